# Optimizing an MI355X kernel written in HIP

```python
import math
import jax
import jax.numpy as jnp
from jax import lax
import numpy as np

D_MODEL = 1024
BATCH = 2
SEQ = 16384
DEPTH = 2

GRID_W = 64
CTX_LEN = 256
N_MIXERS = 2
N_NA_LAYERS = (DEPTH + N_MIXERS - 1) // N_MIXERS
N_DIFF_LAYERS = DEPTH // N_MIXERS
NA_HEADS = 16
NA_HEAD_DIM = D_MODEL // NA_HEADS
NA_WIN_ROWS = 8
NA_WIN_COLS = 16
DIFF_HEADS = 8
DIFF_HEAD_DIM = D_MODEL // DIFF_HEADS // 2
DIFF_EPS = 1e-5
Q_BLOCK = 128
ROPE_BASE = 10000.0
N_EXPERTS = 32
TOP_K = 4
D_FF = D_MODEL
SWIGLU_LIMIT = 7.0
SWIGLU_ALPHA = 1.702
EXPERT_BLOCK = 128
NORM_EPS = 1e-6

kernel_name = 'hybrid_natten_diffattn_moe_dit'


def rmsnorm(x, w, eps=NORM_EPS):
    xf = x.astype(jnp.float32)
    y = xf * lax.rsqrt(jnp.mean(xf * xf, axis=-1, keepdims=True) + eps)
    return (y * w.astype(jnp.float32)).astype(x.dtype)


def modulate(h, shift, scale):
    return h * (1 + scale) + shift


def softmax_f32(s):
    return jax.nn.softmax(s.astype(jnp.float32), axis=-1)


def axial_rope_tables(n_tokens, head_dim):
    t = jnp.arange(n_tokens, dtype=jnp.int32)
    row = (t // GRID_W).astype(jnp.float32)
    col = (t % GRID_W).astype(jnp.float32)
    axis_dim = head_dim // 2
    inv_freq = ROPE_BASE ** (-jnp.arange(0, axis_dim, 2, dtype=jnp.float32) / axis_dim)
    ang = jnp.concatenate([row[:, None] * inv_freq, col[:, None] * inv_freq], axis=-1)
    return jnp.cos(ang), jnp.sin(ang)


def apply_rope(x, cos, sin):
    xf = x.astype(jnp.float32).reshape(x.shape[:-1] + (x.shape[-1] // 2, 2))
    x1, x2 = xf[..., 0], xf[..., 1]
    cs, sn = cos[None, :, None, :], sin[None, :, None, :]
    out = jnp.stack([x1 * cs - x2 * sn, x1 * sn + x2 * cs], axis=-1)
    return out.reshape(x.shape).astype(x.dtype)


def neighbourhood_attention(h, hc, w_qkv, w_o, rpb, need_ctx_out):
    B, S, D = h.shape
    L = hc.shape[1]
    H, dh = NA_HEADS, NA_HEAD_DIM
    rows = S // GRID_W
    wr = min(NA_WIN_ROWS, rows)
    scale = dh ** -0.5
    q, k, v = jnp.split(h @ w_qkv, 3, axis=-1)
    qg = (q * scale).reshape(B, rows, GRID_W, H, dh)
    kg = k.reshape(B, rows, GRID_W, H, dh)
    vg = v.reshape(B, rows, GRID_W, H, dh)
    kc = (hc @ w_qkv[:, D:2 * D]).reshape(B, L, H, dh)
    vc = (hc @ w_qkv[:, 2 * D:]).reshape(B, L, H, dh)
    col = jnp.arange(GRID_W, dtype=jnp.int32)
    c0 = jnp.clip(col - NA_WIN_COLS // 2, 0, GRID_W - NA_WIN_COLS)
    col_idx = c0[:, None] + jnp.arange(NA_WIN_COLS, dtype=jnp.int32)[None, :]
    dc_idx = col_idx - col[:, None] + (NA_WIN_COLS - 1)
    n_nb = wr * NA_WIN_COLS

    def row_block(r):
        r0 = jnp.clip(r - wr // 2, 0, rows - wr)
        qr = lax.dynamic_index_in_dim(qg, r, axis=1, keepdims=False)
        kr = lax.dynamic_slice_in_dim(kg, r0, wr, axis=1)
        vr = lax.dynamic_slice_in_dim(vg, r0, wr, axis=1)
        kn = jnp.take(kr, col_idx, axis=2)
        vn = jnp.take(vr, col_idx, axis=2)
        dr_idx = r0 + jnp.arange(wr, dtype=jnp.int32) - r + (NA_WIN_ROWS - 1)
        bias = rpb[:, dr_idx[None, :, None], dc_idx[:, None, :]]
        s_nb = jnp.einsum('bqhd,brqjhd->bhqrj', qr, kn) + bias[None]
        s_ctx = jnp.einsum('bqhd,bkhd->bhqk', qr, kc)
        p = softmax_f32(jnp.concatenate([s_nb.reshape(B, H, GRID_W, n_nb), s_ctx], axis=-1)).astype(h.dtype)
        p_nb = p[..., :n_nb].reshape(B, H, GRID_W, wr, NA_WIN_COLS)
        o = jnp.einsum('bhqrj,brqjhd->bqhd', p_nb, vn) + jnp.einsum('bhqk,bkhd->bqhd', p[..., n_nb:], vc)
        return o.reshape(B, GRID_W, D)

    o = lax.map(row_block, jnp.arange(rows, dtype=jnp.int32))
    out = o.transpose(1, 0, 2, 3).reshape(B, S, D) @ w_o
    oc = None
    if need_ctx_out:
        qc = (hc @ w_qkv[:, :D]).reshape(B, L, H, dh) * scale
        pc = softmax_f32(jnp.einsum('bqhd,bkhd->bhqk', qc, kc)).astype(h.dtype)
        oc = jnp.einsum('bhqk,bkhd->bqhd', pc, vc).reshape(B, L, D) @ w_o
    return out, oc


def diff_attention(h, hc, w_qkv, w_o, lq1, lk1, lq2, lk2, subln, lambda_init, need_ctx_out):
    B, S, D = h.shape
    L = hc.shape[1]
    H, dh = DIFF_HEADS, DIFF_HEAD_DIM
    scale = dh ** -0.5
    q, k, v = jnp.split(h @ w_qkv, 3, axis=-1)
    cos, sin = axial_rope_tables(S, dh)
    q = apply_rope(q.reshape(B, S, 2 * H, dh), cos, sin) * scale
    k = apply_rope(k.reshape(B, S, 2 * H, dh), cos, sin)
    v = v.reshape(B, S, H, 2 * dh)
    kc = (hc @ w_qkv[:, D:2 * D]).reshape(B, L, 2 * H, dh)
    vc = (hc @ w_qkv[:, 2 * D:]).reshape(B, L, H, 2 * dh)
    f32 = jnp.float32
    lam = (jnp.exp(jnp.sum(lq1.astype(f32) * lk1.astype(f32)))
           - jnp.exp(jnp.sum(lq2.astype(f32) * lk2.astype(f32))) + lambda_init)
    k_all = jnp.concatenate([k, kc], axis=1)
    v_all = jnp.concatenate([v, vc], axis=1)

    def diff_map(qi, keys, vals):
        nq, nk = qi.shape[1], keys.shape[1]
        p = softmax_f32(jnp.einsum('bqhd,bkhd->bhqk', qi, keys)).reshape(B, H, 2, nq, nk)
        a = (p[:, :, 0] - lam * p[:, :, 1]).astype(vals.dtype)
        return jnp.einsum('bhqk,bkhd->bqhd', a, vals)

    def finish(o, n):
        return (rmsnorm(o, subln, DIFF_EPS) * (1.0 - lambda_init)).reshape(B, n, D) @ w_o

    n_blk = S // Q_BLOCK
    qb = q.reshape(B, n_blk, Q_BLOCK, 2 * H, dh).transpose(1, 0, 2, 3, 4)
    o = lax.map(lambda qi: diff_map(qi, k_all, v_all), qb)
    out = finish(o.transpose(1, 0, 2, 3, 4).reshape(B, S, H, 2 * dh), S)
    oc = None
    if need_ctx_out:
        qc = (hc @ w_qkv[:, :D]).reshape(B, L, 2 * H, dh) * scale
        oc = finish(diff_map(qc, kc, vc), L)
    return out, oc


def moe_ffn(h, w_router, b_router, w_gate_up, b_gate_up, w_down, b_down):
    N, D = h.shape
    logits = (h @ w_router).astype(jnp.float32) + b_router.astype(jnp.float32)
    top_val, top_idx = lax.top_k(logits, TOP_K)
    gates = jax.nn.softmax(top_val, axis=-1).astype(h.dtype)
    A = N * TOP_K
    e_flat = top_idx.reshape(A).astype(jnp.int32)
    order = jnp.argsort(e_flat)
    pos_sorted = jnp.zeros((A,), jnp.int32).at[order].set(jnp.arange(A, dtype=jnp.int32))
    counts = jnp.bincount(e_flat, length=N_EXPERTS).astype(jnp.int32)
    starts = jnp.cumsum(counts) - counts
    padded = (counts + EXPERT_BLOCK - 1) // EXPERT_BLOCK * EXPERT_BLOCK
    pad_ends = jnp.cumsum(padded)
    pad_starts = pad_ends - padded
    dest = pad_starts[e_flat] + pos_sorted - starts[e_flat]
    n_blocks = (A + N_EXPERTS * (EXPERT_BLOCK - 1) + EXPERT_BLOCK - 1) // EXPERT_BLOCK
    tok = jnp.arange(A, dtype=jnp.int32) // TOP_K
    buf = jnp.zeros((n_blocks * EXPERT_BLOCK, D), h.dtype).at[dest].set(h[tok])
    block_start = jnp.arange(n_blocks, dtype=jnp.int32) * EXPERT_BLOCK
    block_expert = jnp.minimum(jnp.searchsorted(pad_ends, block_start, side='right'), N_EXPERTS - 1)

    def expert_block(args):
        xb, e = args
        gu = xb @ w_gate_up[e] + b_gate_up[e]
        g, u = gu[:, :D_FF], gu[:, D_FF:]
        g = jnp.minimum(g, SWIGLU_LIMIT)
        u = jnp.clip(u, -SWIGLU_LIMIT, SWIGLU_LIMIT)
        act = (u + 1) * (g * jax.nn.sigmoid(SWIGLU_ALPHA * g))
        return act @ w_down[e] + b_down[e]

    out = lax.map(expert_block, (buf.reshape(n_blocks, EXPERT_BLOCK, D), block_expert)).reshape(-1, D)
    y = out[dest].reshape(N, TOP_K, D)
    return jnp.einsum('nk,nkd->nd', gates, y)


def setup_inputs(seed: int = 0) -> dict:
    key = jax.random.key(seed)
    ks = jax.random.split(key, 26)
    f32 = jnp.float32
    D, E, F = D_MODEL, N_EXPERTS, D_FF

    def nrm(k, shape, s):
        return jax.random.normal(k, shape, f32) * s

    def gain(k, shape):
        return 1.0 + nrm(k, shape, 0.01)

    return {
        'x': nrm(ks[0], (BATCH, SEQ, D), 1.0),
        'c': nrm(ks[1], (BATCH, D), 1.0),
        'ctx': nrm(ks[2], (BATCH, CTX_LEN, D), 1.0),
        'c_ctx': nrm(ks[3], (D,), 1.0),
        'w_mod': nrm(ks[4], (DEPTH, D, 6 * D), 0.5 * D ** -0.5),
        'b_mod': nrm(ks[5], (DEPTH, 6 * D), 0.01),
        'norm_mix_pre': gain(ks[6], (DEPTH, D)),
        'norm_mix_post': gain(ks[7], (DEPTH, D)),
        'norm_ffn_pre': gain(ks[8], (DEPTH, D)),
        'norm_ffn_post': gain(ks[9], (DEPTH, D)),
        'na_w_qkv': nrm(ks[10], (N_NA_LAYERS, D, 3 * D), D ** -0.5),
        'na_w_o': nrm(ks[11], (N_NA_LAYERS, D, D), D ** -0.5),
        'na_rpb': nrm(ks[12], (N_NA_LAYERS, NA_HEADS, 2 * NA_WIN_ROWS - 1, 2 * NA_WIN_COLS - 1), 0.1),
        'diff_w_qkv': nrm(ks[13], (N_DIFF_LAYERS, D, 3 * D), D ** -0.5),
        'diff_w_o': nrm(ks[14], (N_DIFF_LAYERS, D, D), D ** -0.5),
        'diff_lambda_q1': nrm(ks[15], (N_DIFF_LAYERS, DIFF_HEAD_DIM), 0.1),
        'diff_lambda_k1': nrm(ks[16], (N_DIFF_LAYERS, DIFF_HEAD_DIM), 0.1),
        'diff_lambda_q2': nrm(ks[17], (N_DIFF_LAYERS, DIFF_HEAD_DIM), 0.1),
        'diff_lambda_k2': nrm(ks[18], (N_DIFF_LAYERS, DIFF_HEAD_DIM), 0.1),
        'diff_subln': gain(ks[19], (N_DIFF_LAYERS, 2 * DIFF_HEAD_DIM)),
        'moe_w_router': nrm(ks[20], (DEPTH, D, E), D ** -0.5),
        'moe_b_router': nrm(ks[21], (DEPTH, E), 0.01),
        'moe_w_gate_up': nrm(ks[22], (DEPTH, E, D, 2 * F), D ** -0.5),
        'moe_b_gate_up': nrm(ks[23], (DEPTH, E, 2 * F), 0.01),
        'moe_w_down': nrm(ks[24], (DEPTH, E, F, D), F ** -0.5),
        'moe_b_down': nrm(ks[25], (DEPTH, E, D), 0.01),
    }


def reference(x, c, ctx, c_ctx, w_mod, b_mod, norm_mix_pre, norm_mix_post, norm_ffn_pre, norm_ffn_post,
              na_w_qkv, na_w_o, na_rpb,
              diff_w_qkv, diff_w_o, diff_lambda_q1, diff_lambda_k1, diff_lambda_q2, diff_lambda_k2, diff_subln,
              moe_w_router, moe_b_router, moe_w_gate_up, moe_b_gate_up, moe_w_down, moe_b_down):
    B, S, D = x.shape
    L = ctx.shape[1]
    xc = ctx
    silu_c = jax.nn.silu(c)
    silu_cc = jax.nn.silu(c_ctx)
    for i in range(DEPTH):
        last = i == DEPTH - 1
        mod = silu_c @ w_mod[i] + b_mod[i]
        mod_c = silu_cc @ w_mod[i] + b_mod[i]
        sh_a, sc_a, g_a, sh_f, sc_f, g_f = jnp.split(mod[:, None, :], 6, axis=-1)
        shc_a, scc_a, gc_a, shc_f, scc_f, gc_f = jnp.split(mod_c, 6, axis=-1)
        h = modulate(rmsnorm(x, norm_mix_pre[i]), sh_a, sc_a)
        hc = modulate(rmsnorm(xc, norm_mix_pre[i]), shc_a, scc_a)
        j = i // N_MIXERS
        if i % N_MIXERS == 0:
            o, oc = neighbourhood_attention(h, hc, na_w_qkv[j], na_w_o[j], na_rpb[j], not last)
        else:
            lambda_init = 0.8 - 0.6 * math.exp(-0.3 * i)
            o, oc = diff_attention(h, hc, diff_w_qkv[j], diff_w_o[j], diff_lambda_q1[j], diff_lambda_k1[j],
                                   diff_lambda_q2[j], diff_lambda_k2[j], diff_subln[j], lambda_init, not last)
        x = x + g_a * rmsnorm(o, norm_mix_post[i])
        h = modulate(rmsnorm(x, norm_ffn_pre[i]), sh_f, sc_f).reshape(B * S, D)
        moe_args = (moe_w_router[i], moe_b_router[i], moe_w_gate_up[i], moe_b_gate_up[i],
                    moe_w_down[i], moe_b_down[i])
        if last:
            y = moe_ffn(h, *moe_args).reshape(B, S, D)
        else:
            xc = xc + gc_a * rmsnorm(oc, norm_mix_post[i])
            hc = modulate(rmsnorm(xc, norm_ffn_pre[i]), shc_f, scc_f).reshape(B * L, D)
            y_all = moe_ffn(jnp.concatenate([h, hc], axis=0), *moe_args)
            y = y_all[:B * S].reshape(B, S, D)
            xc = xc + gc_f * rmsnorm(y_all[B * S:].reshape(B, L, D), norm_ffn_post[i])
        x = x + g_f * rmsnorm(y, norm_ffn_post[i])
    return x
```

```cpp
#include <hip/hip_runtime.h>
#include <cstdio>
#include <cstdint>

#ifndef MK_SPLIT
#define MK_SPLIT 0
#endif

#ifndef REP_DIFF
#define REP_DIFF 1
#endif
#ifndef REP_MOE
#define REP_MOE 1
#endif
#ifndef REP_PRO
#define REP_PRO 1
#endif
#ifndef REP_NA
#define REP_NA 1
#endif
#ifndef REP_ABL
#define REP_ABL 0
#endif
#ifndef ABLV
#define ABLV 0
#endif
#ifndef DENSE_FP8
#define DENSE_FP8 3
#endif
#ifndef REP_DENSE
#define REP_DENSE 1
#endif
#define LAS __attribute__((address_space(3)))
#define GAS __attribute__((address_space(1)))
typedef unsigned short bf16_t;
typedef short bf16x8 __attribute__((ext_vector_type(8)));
typedef short s16x4 __attribute__((ext_vector_type(4)));
typedef float f32x2 __attribute__((ext_vector_type(2)));
typedef float f32x4 __attribute__((ext_vector_type(4)));
typedef float f32x16 __attribute__((ext_vector_type(16)));
typedef unsigned u32x2 __attribute__((ext_vector_type(2)));
typedef unsigned u32x4 __attribute__((ext_vector_type(4)));

constexpr int DM = 1024, BATCH = 2, SEQ = 16384, NLAT = BATCH * SEQ, CTXL = 256, NCTX = BATCH * CTXL, NTOK = NLAT + NCTX;
constexpr int NE = 32, FF = 1024, MAXTILES = 552, GRIDW = 64;
constexpr float NORM_EPS = 1e-6f, DIFF_EPS = 1e-5f, LOG2E = 1.4426950408889634f, QSCALE = 0.125f * 1.4426950408889634f;
constexpr float LAMBDA_INIT = 0.3555090675909693f;
constexpr float SWIGLU_LIMIT = 7.0f, SWIGLU_ALPHA = 1.702f;

constexpr size_t MiB = 1u << 20;
constexpr size_t WS_CTL = 0, CTL_ZERO_BYTES = 1 * MiB;
constexpr size_t WS_MOD = 1 * MiB;
constexpr size_t WS_WRT = 1 * MiB + 512 * 1024;
constexpr size_t WS_ROPE = 2 * MiB;
constexpr size_t WS_WQKV = 8 * MiB;
constexpr size_t WS_WO = 20 * MiB;
constexpr size_t WS_WGU = 24 * MiB;
constexpr size_t WS_WDN = 280 * MiB;
constexpr size_t WS_XS = 408 * MiB;
constexpr size_t WS_XN = 538 * MiB;
constexpr size_t WS_Q = 603 * MiB, WS_K = 668 * MiB, WS_V = 733 * MiB, WS_O = 798 * MiB, WS_T = 863 * MiB;
constexpr size_t WS_ACT = 928 * MiB;
constexpr size_t WS_Y = 1204 * MiB;
constexpr size_t WS_TOKOF = 1480 * MiB;
constexpr size_t WS_SLOT = 1485 * MiB;
constexpr size_t WS_GATE = 1486 * MiB;
constexpr size_t WS_XN8 = 1487 * MiB;
constexpr size_t WS_END = 1520 * MiB;
static_assert((size_t)NTOK * DM * 4 == 130 * MiB && (size_t)NTOK * DM * 2 == 65 * MiB && (size_t)MAXTILES * 256 * DM * 2 == 276 * MiB, "ws map");
constexpr int CW_BAR = 4096;
constexpr int CW_CNT = 8192;

constexpr int RING_BYTES = 131072;
constexpr int TAB_OFF = RING_BYTES;
constexpr int MISC_OFF = RING_BYTES + 12288;
constexpr int LDS_BYTES = 147456;

__device__ __forceinline__ unsigned cvt_pk_bf16(float lo, float hi) { unsigned r; asm volatile("v_cvt_pk_bf16_f32 %0, %1, %2" : "=v"(r) : "v"(lo), "v"(hi)); return r; }
__device__ __forceinline__ float bflo(unsigned w) { return __uint_as_float(w << 16); }
__device__ __forceinline__ float bfhi(unsigned w) { return __uint_as_float(w & 0xffff0000u); }
#define DPPF(x, ctrl, rmask, oldv) __builtin_bit_cast(float, __builtin_amdgcn_update_dpp(__builtin_bit_cast(int, (float)(oldv)), __builtin_bit_cast(int, (float)(x)), ctrl, rmask, 0xF, false))
__device__ __forceinline__ float wave_sum(float v) {
    v += DPPF(v, 0xB1, 0xF, 0.f); v += DPPF(v, 0x4E, 0xF, 0.f); v += DPPF(v, 0x141, 0xF, 0.f); v += DPPF(v, 0x140, 0xF, 0.f);
    v += DPPF(v, 0x142, 0xA, 0.f); v += DPPF(v, 0x143, 0xC, 0.f);
    return __builtin_bit_cast(float, __builtin_amdgcn_readlane(__builtin_bit_cast(int, v), 63));
}
__device__ __forceinline__ float wave_max(float v) {
    v = fmaxf(v, DPPF(v, 0xB1, 0xF, v)); v = fmaxf(v, DPPF(v, 0x4E, 0xF, v)); v = fmaxf(v, DPPF(v, 0x141, 0xF, v)); v = fmaxf(v, DPPF(v, 0x140, 0xF, v));
    v = fmaxf(v, DPPF(v, 0x142, 0xA, v)); v = fmaxf(v, DPPF(v, 0x143, 0xC, v));
    return __builtin_bit_cast(float, __builtin_amdgcn_readlane(__builtin_bit_cast(int, v), 63));
}
#define LDS_WAIT() asm volatile("s_waitcnt lgkmcnt(0)" ::: "memory")
#define VM_WAIT() asm volatile("s_waitcnt vmcnt(0)" ::: "memory")

namespace pg8 {
constexpr int BM = 256, BK = 64, HALF = 128, HTB = HALF * BK * 2, STAGE_BYTES = 8 * HTB, NXCD = 8, WGM = 8;
__host__ __device__ __forceinline__ int lds_byte(int r, int c) { const int st = (r >> 4) * 2 + (c >> 5), rr = r & 15, cc = c & 31, ob = rr * 64 + cc * 2; return st * 1024 + (ob ^ (((ob >> 9) & 1) << 5)); }
__host__ __device__ __forceinline__ void stage_rc(int b, int& R, int& C) { const int st = b / 1024, sb = b % 1024, swz = sb ^ (((sb >> 9) & 1) << 5); R = (st >> 1) * 16 + swz / 64; C = (st & 1) * 32 + (swz % 64) / 2; }
__host__ __device__ __forceinline__ int perm32(int rho) { const int n = rho >> 4, i = rho & 15; return 8 * (i >> 2) + 4 * n + (i & 3); }

struct Unit { int pm, pn, e; };

struct DenseOrder {
    int nM, nN, nwg, G, c;
    __device__ void init(int nM_, int nN_, int G_, int c_) { nM = nM_; nN = nN_; nwg = nM * nN; G = G_; c = c_; }
    __device__ bool next(int i, Unit& u) const {
        const long L = (long)i * G + c; if (L >= nwg) return false;
        int wgid = (int)L; { const int q = nwg / NXCD, r = nwg % NXCD, xcd = wgid % NXCD, off = wgid / NXCD; wgid = (xcd < r ? xcd * (q + 1) : r * (q + 1) + (xcd - r) * q) + off; }
        const int nig = WGM * nN, gid = wgid / nig, fm = gid * WGM, gsz = (nM - fm) < WGM ? (nM - fm) : WGM;
        u.pm = fm + ((wgid % nig) % gsz); u.pn = (wgid % nig) / gsz; u.e = 0; return true;
    }
};
struct MoeOrder {
    int nM, nN, nwg, G, c; const LAS int* tile_e;
    __device__ void init(int nM_, int nN_, int G_, int c_, const LAS int* te) { nM = nM_; nN = nN_; nwg = nM * nN; G = G_; c = c_; tile_e = te; }
    __device__ bool next(int i, Unit& u) const {
        const long L = (long)i * G + c; if (L >= nwg) return false;
        int wgid = (int)L; { const int q = nwg / NXCD, r = nwg % NXCD, xcd = wgid % NXCD, off = wgid / NXCD; wgid = (xcd < r ? xcd * (q + 1) : r * (q + 1) + (xcd - r) * q) + off; }
        const int nig = WGM * nN, gid = wgid / nig, fm = gid * WGM, gsz = (nM - fm) < WGM ? (nM - fm) : WGM;
        u.pm = fm + ((wgid % nig) % gsz); u.pn = (wgid % nig) / gsz; u.e = tile_e[u.pm]; return true;
    }
};
struct RowDense { static constexpr bool LOADS = false; __device__ __forceinline__ unsigned row(const Unit& u, int r) const { return (unsigned)(u.pm * BM + r); } };
struct RowMoe {
    static constexpr bool LOADS = true; const int* tokof; const LAS int* cnt; const LAS int* tstart;
    __device__ __forceinline__ unsigned row(const Unit& u, int r) const { const int pos = (u.pm - tstart[u.e]) * BM + r; return pos < cnt[u.e] ? (unsigned)tokof[u.e * NTOK + pos] : 0u; }
};

struct EpiQKV {
    static constexpr bool PERM = true;
    bf16_t* Q; size_t split_stride; float qscale; const float* rope; float ascale;
    __device__ __forceinline__ void operator()(const f32x4 (&acc)[2][2][4][2], const Unit& u, int wr, int wc, int fr, int fq) const {
        const int t = u.pn >> 2, colt = (u.pn & 3) * BM;
        bf16_t* base = Q + (size_t)t * split_stride;
        const float sc = (t == 0) ? qscale : 1.f;
        const int row0 = u.pm * BM + wr * 64 + fr, col0 = colt + wc * 32 + 8 * fq;
        const bool do_rope = (rope != nullptr) && (t < 2) && (u.pm < NLAT / BM), f8qk = (rope != nullptr);
#pragma unroll
        for (int ai = 0; ai < 2; ++ai)
#pragma unroll
            for (int m = 0; m < 4; ++m) {
                const int row = row0 + ai * HALF + m * 16;
                bf16_t* rowp = base + (size_t)row * DM + col0;
#pragma unroll
                for (int bj = 0; bj < 2; ++bj) {
                    f32x4 v0 = acc[ai][bj][m][0] * ascale, v1 = acc[ai][bj][m][1] * ascale;
                    if (do_rope) {
                        const int tpos = row & (SEQ - 1), j0 = ((col0 + bj * HALF) & 63) >> 1;
                        const f32x4 cs0 = *(const f32x4*)(rope + ((size_t)tpos * 32 + j0) * 2), cs1 = *(const f32x4*)(rope + ((size_t)tpos * 32 + j0 + 2) * 2);
                        f32x4 w0, w1;
                        w0[0] = v0[0] * cs0[0] - v0[1] * cs0[1]; w0[1] = v0[0] * cs0[1] + v0[1] * cs0[0];
                        w0[2] = v0[2] * cs0[2] - v0[3] * cs0[3]; w0[3] = v0[2] * cs0[3] + v0[3] * cs0[2];
                        w1[0] = v1[0] * cs1[0] - v1[1] * cs1[1]; w1[1] = v1[0] * cs1[1] + v1[1] * cs1[0];
                        w1[2] = v1[2] * cs1[2] - v1[3] * cs1[3]; w1[3] = v1[2] * cs1[3] + v1[3] * cs1[2];
                        v0 = w0; v1 = w1;
                    }
                    if (f8qk && t < 2) {
                        const float s8 = (t == 0) ? LOG2E * 0.35355339059f : 0.35355339059f; v0 = v0 * s8; v1 = v1 * s8;
                        int w0 = __builtin_amdgcn_cvt_pk_fp8_f32(v0[0], v0[1], 0, false); w0 = __builtin_amdgcn_cvt_pk_fp8_f32(v0[2], v0[3], w0, true);
                        int w1 = __builtin_amdgcn_cvt_pk_fp8_f32(v1[0], v1[1], 0, false); w1 = __builtin_amdgcn_cvt_pk_fp8_f32(v1[2], v1[3], w1, true);
                        *(u32x2*)((unsigned char*)base + (size_t)row * DM + col0 + bj * HALF) = (u32x2){(unsigned)w0, (unsigned)w1};
                    } else {
                    v0 = v0 * sc; v1 = v1 * sc;
                    u32x4 w; w.x = cvt_pk_bf16(v0[0], v0[1]); w.y = cvt_pk_bf16(v0[2], v0[3]); w.z = cvt_pk_bf16(v1[0], v1[1]); w.w = cvt_pk_bf16(v1[2], v1[3]);
                    *(u32x4*)(rowp + bj * HALF) = w; }
                }
            }
    }
};
struct EpiPlain {
    static constexpr bool PERM = true;
    bf16_t* O; const float* bias; float ascale;
    __device__ __forceinline__ void operator()(const f32x4 (&acc)[2][2][4][2], const Unit& u, int wr, int wc, int fr, int fq) const {
        const int row0 = u.pm * BM + wr * 64 + fr, col0 = u.pn * BM + wc * 32 + 8 * fq;
        f32x4 bv[2][2];
#pragma unroll
        for (int bj = 0; bj < 2; ++bj)
#pragma unroll
            for (int n = 0; n < 2; ++n) bv[bj][n] = bias ? *(const f32x4*)(bias + (size_t)u.e * DM + col0 + bj * HALF + 4 * n) : (f32x4){0.f, 0.f, 0.f, 0.f};
#pragma unroll
        for (int ai = 0; ai < 2; ++ai)
#pragma unroll
            for (int m = 0; m < 4; ++m) {
                bf16_t* rowp = O + (size_t)(row0 + ai * HALF + m * 16) * DM + col0;
#pragma unroll
                for (int bj = 0; bj < 2; ++bj) {
                    const f32x4 v0 = acc[ai][bj][m][0] * ascale + bv[bj][0], v1 = acc[ai][bj][m][1] * ascale + bv[bj][1];
                    u32x4 w; w.x = cvt_pk_bf16(v0[0], v0[1]); w.y = cvt_pk_bf16(v0[2], v0[3]); w.z = cvt_pk_bf16(v1[0], v1[1]); w.w = cvt_pk_bf16(v1[2], v1[3]);
                    *(u32x4*)(rowp + bj * HALF) = w;
                }
            }
    }
};
__device__ __forceinline__ float swiglu1(float g, float u) {
    g = fminf(g, SWIGLU_LIMIT); u = fminf(fmaxf(u, -SWIGLU_LIMIT), SWIGLU_LIMIT);
    const float sg = __builtin_amdgcn_rcpf(1.f + __builtin_amdgcn_exp2f(-SWIGLU_ALPHA * LOG2E * g));
    return (u + 1.f) * (g * sg);
}
__device__ __forceinline__ f32x2 swiglu2(f32x2 g, f32x2 u) {
    g = (f32x2){fminf(g[0], SWIGLU_LIMIT), fminf(g[1], SWIGLU_LIMIT)};
    u = (f32x2){fminf(fmaxf(u[0], -SWIGLU_LIMIT), SWIGLU_LIMIT), fminf(fmaxf(u[1], -SWIGLU_LIMIT), SWIGLU_LIMIT)};
    const f32x2 z = g * (f32x2){-SWIGLU_ALPHA * LOG2E, -SWIGLU_ALPHA * LOG2E};
    const f32x2 d = (f32x2){__builtin_amdgcn_exp2f(z[0]), __builtin_amdgcn_exp2f(z[1])} + (f32x2){1.f, 1.f};
    const f32x2 sg = (f32x2){__builtin_amdgcn_rcpf(d[0]), __builtin_amdgcn_rcpf(d[1])};
    return (u + (f32x2){1.f, 1.f}) * (g * sg);
}
struct EpiSwiGLU {
    static constexpr bool PERM = true;
    unsigned char* ACT8p; const float* bgu;
    __device__ __forceinline__ void operator()(const f32x4 (&acc)[2][2][4][2], const Unit& u, int wr, int wc, int fr, int fq) const {
        const int row0 = u.pm * BM + wr * 64 + fr, cj = u.pn * HALF + wc * 32 + 8 * fq;
        f32x4 bg[2], bu[2];
#pragma unroll
        for (int n = 0; n < 2; ++n) { bg[n] = *(const f32x4*)(bgu + (size_t)u.e * 2048 + cj + 4 * n); bu[n] = *(const f32x4*)(bgu + (size_t)u.e * 2048 + 1024 + cj + 4 * n); }
#pragma unroll
        for (int ai = 0; ai < 2; ++ai)
#pragma unroll
            for (int m = 0; m < 4; ++m) {
                unsigned char* rowp = ACT8p + (size_t)(row0 + ai * HALF + m * 16) * DM + cj;
                const f32x4 g0 = acc[ai][0][m][0] * 0.03125f + bg[0], g1 = acc[ai][0][m][1] * 0.03125f + bg[1], u0 = acc[ai][1][m][0] * 0.03125f + bu[0], u1 = acc[ai][1][m][1] * 0.03125f + bu[1];
                const f32x2 s00 = swiglu2((f32x2){g0[0], g0[1]}, (f32x2){u0[0], u0[1]}), s01 = swiglu2((f32x2){g0[2], g0[3]}, (f32x2){u0[2], u0[3]});
                const f32x2 s10 = swiglu2((f32x2){g1[0], g1[1]}, (f32x2){u1[0], u1[1]}), s11 = swiglu2((f32x2){g1[2], g1[3]}, (f32x2){u1[2], u1[3]});
                int w0 = __builtin_amdgcn_cvt_pk_fp8_f32(s00[0], s00[1], 0, false); w0 = __builtin_amdgcn_cvt_pk_fp8_f32(s01[0], s01[1], w0, true);
                int w1 = __builtin_amdgcn_cvt_pk_fp8_f32(s10[0], s10[1], 0, false); w1 = __builtin_amdgcn_cvt_pk_fp8_f32(s11[0], s11[1], w1, true);
                *(u32x2*)rowp = (u32x2){(unsigned)w0, (unsigned)w1};
            }
    }
};

__device__ __forceinline__ void glds16s(const void* sbase, unsigned voff, unsigned lds_dst) {
    unsigned keep;
    asm volatile("s_mov_b32 %0, m0\n\ts_mov_b32 m0, %3\n\ts_nop 0\n\tglobal_load_lds_dwordx4 %1, %2\n\ts_mov_b32 m0, %0" : "=&s"(keep) : "v"(voff), "s"(sbase), "s"(lds_dst) : "memory");
}
template <int ES, class Epi, class Sched, class RowMap>
__device__ __forceinline__ void gemm_phase(LAS unsigned char* lds, const void* A, const void* Bt, int K, size_t b_estride, const Sched& S, const Epi& E, const RowMap& RM) {
    typedef int v8i_t __attribute__((ext_vector_type(8))); typedef int v4i_t __attribute__((ext_vector_type(4)));
    constexpr int sclB = 0, sclA = 0;
    int tid = threadIdx.x; asm volatile("" : "+v"(tid));
    const int wid = __builtin_amdgcn_readfirstlane(tid >> 6), lane = tid & 63, wr = wid >> 2, wc = wid & 3, fr = lane & 15, fq = lane >> 4;
    const int nt = K * ES / (BK * 2);
    unsigned voffB[2];
#pragma unroll
    for (int i = 0; i < 2; ++i) { int R, C; stage_rc(tid * 16 + i * 8192, R, C); const int Rb = Epi::PERM ? ((R & ~31) + perm32(R & 31)) : R; voffB[i] = (unsigned)(Rb * K * ES + C * 2); }
    const unsigned kstep = (unsigned)(BK * 2);
    const size_t hstep = (size_t)HALF * K * ES, tstep = 2 * hstep;
    const unsigned ldsw = (unsigned)wid * 1024u, lds0 = (unsigned)(uintptr_t)lds;
    const int aoff = lds_byte(wr * 64 + fr, fq * 8), boff = lds_byte(wc * 32 + fr, fq * 8);
#define PG8_SA(b, h) (((b) * 2 + (h)) * HTB)
#define PG8_SB(b, h) ((4 + (b) * 2 + (h)) * HTB)
#define PG8_STAGE_B(bufoff, gbase) do { _Pragma("unroll") for (int _i = 0; _i < 2; ++_i) \
        glds16s((const char*)(gbase), voffB[_i], (unsigned)__builtin_amdgcn_readfirstlane((int)(lds0 + (bufoff) + ldsw + _i * 8192))); } while (0)
#define PG8_STAGE_A(bufoff, offs, kb) do { _Pragma("unroll") for (int _i = 0; _i < 2; ++_i) \
        glds16s((const char*)A + (kb), (offs)[_i], (unsigned)__builtin_amdgcn_readfirstlane((int)(lds0 + (bufoff) + ldsw + _i * 8192))); } while (0)
#define PG8_LDA(dst, b, h) do { _Pragma("unroll") for (int m = 0; m < 4; ++m) _Pragma("unroll") for (int k = 0; k < 2; ++k) dst[m][k] = *(const LAS bf16x8*)(lds + PG8_SA(b, h) + aoff + m * 2048 + k * 1024); } while (0)
#define PG8_LDB(dst, b, h) do { _Pragma("unroll") for (int n = 0; n < 2; ++n) _Pragma("unroll") for (int k = 0; k < 2; ++k) dst[n][k] = *(const LAS bf16x8*)(lds + PG8_SB(b, h) + boff + n * 2048 + k * 1024); } while (0)
#define PG8_CAT(x0, x1) __builtin_shufflevector(__builtin_bit_cast(v4i_t, x0), __builtin_bit_cast(v4i_t, x1), 0, 1, 2, 3, 4, 5, 6, 7)
#define PG8_MMA(ai, bj, At, Bt_) do { __builtin_amdgcn_s_setprio(1); \
        if constexpr (ES == 2) { _Pragma("unroll") for (int m = 0; m < 4; ++m) _Pragma("unroll") for (int n = 0; n < 2; ++n) _Pragma("unroll") for (int k = 0; k < 2; ++k) \
            acc[ai][bj][m][n] = __builtin_amdgcn_mfma_f32_16x16x32_bf16(Bt_[n][k], At[m][k], acc[ai][bj][m][n], 0, 0, 0); } \
        else { _Pragma("unroll") for (int m = 0; m < 4; ++m) _Pragma("unroll") for (int n = 0; n < 2; ++n) \
            acc[ai][bj][m][n] = __builtin_amdgcn_mfma_scale_f32_16x16x128_f8f6f4(PG8_CAT(Bt_[n][0], Bt_[n][1]), PG8_CAT(At[m][0], At[m][1]), acc[ai][bj][m][n], 0, 0, 0, sclB, 0, sclA); } \
        __builtin_amdgcn_s_setprio(0); } while (0)
#define PG8_WAIT_V(n) asm volatile("s_waitcnt vmcnt(" #n ")" ::: "memory")
#define PG8_WAIT_L(n) asm volatile("s_waitcnt lgkmcnt(" #n ")" ::: "memory")
#define PG8_BAR __builtin_amdgcn_s_barrier()
#define PG8_SCHED __builtin_amdgcn_sched_barrier(0)
#define PG8_AOFF(dst, u) do { int t_ = tid; asm volatile("" : "+v"(t_)); _Pragma("unroll") for (int _i = 0; _i < 2; ++_i) { int R_, C_; stage_rc(t_ * 16 + _i * 8192, R_, C_); \
        _Pragma("unroll") for (int _h = 0; _h < 2; ++_h) dst[_h][_i] = RM.row(u, _h * HALF + R_) * (unsigned)(K * ES) + (unsigned)C_ * 2u; } } while (0)
#define PG8_ARAW(dst, u) do { int t_ = tid; asm volatile("" : "+v"(t_)); _Pragma("unroll") for (int _i = 0; _i < 2; ++_i) { int R_, C_; stage_rc(t_ * 16 + _i * 8192, R_, C_); \
        _Pragma("unroll") for (int _h = 0; _h < 2; ++_h) dst[_h][_i] = RM.row(u, _h * HALF + R_); } } while (0)
#define PG8_AFIN(dst, raw) do { int t_ = tid; asm volatile("" : "+v"(t_)); _Pragma("unroll") for (int _i = 0; _i < 2; ++_i) { int R_, C_; stage_rc(t_ * 16 + _i * 8192, R_, C_); \
        _Pragma("unroll") for (int _h = 0; _h < 2; ++_h) dst[_h][_i] = raw[_h][_i] * (unsigned)(K * ES) + (unsigned)C_ * 2u; } } while (0)
    Unit cur, nxt, nn; int ui = 0;
    if (!S.next(0, cur)) return;
    bool has_next = S.next(1, nxt);
    unsigned offc[2][2], offn[2][2];
    PG8_AOFF(offc, cur);
    if (has_next) PG8_AOFF(offn, nxt); else { _Pragma("unroll") for (int h = 0; h < 2; ++h) _Pragma("unroll") for (int i = 0; i < 2; ++i) offn[h][i] = offc[h][i]; }
    if (RowMap::LOADS) { PG8_WAIT_V(0); PG8_WAIT_L(0); }
    f32x4 acc[2][2][4][2];
#pragma unroll
    for (int a = 0; a < 2; ++a)
#pragma unroll
        for (int b = 0; b < 2; ++b)
#pragma unroll
            for (int m = 0; m < 4; ++m)
#pragma unroll
                for (int n = 0; n < 2; ++n) acc[a][b][m][n] = (f32x4){0.f, 0.f, 0.f, 0.f};
    bf16x8 At[4][2], B0[2][2], B1[2][2];
    const char* cB = (const char*)Bt + (size_t)cur.e * b_estride + (size_t)cur.pn * tstep;
    PG8_STAGE_B(PG8_SB(0, 0), cB); PG8_STAGE_B(PG8_SB(0, 1), cB + hstep); PG8_STAGE_A(PG8_SA(0, 0), offc[0], 0u); PG8_STAGE_A(PG8_SA(0, 1), offc[1], 0u);
    if (wr == 1) PG8_BAR;
    PG8_WAIT_V(2); PG8_BAR;
    PG8_STAGE_B(PG8_SB(1, 0), cB + kstep); PG8_STAGE_A(PG8_SA(1, 0), offc[0], kstep); PG8_STAGE_B(PG8_SB(1, 1), cB + hstep + kstep);
    PG8_WAIT_V(6); PG8_BAR;
    for (;;) {
        const char* nB = has_next ? (const char*)Bt + (size_t)nxt.e * b_estride + (size_t)nxt.pn * tstep : cB;
        for (int t = 0; t < nt; t += 2) {
            const bool last = (t == nt - 2);
            const unsigned kb1 = (unsigned)(t + 1) * kstep, kb2 = last ? 0u : (unsigned)(t + 2) * kstep, kb3 = kb2 + kstep;
#define PG8_STAGE_A2(bufoff, h, kb) do { if (last) PG8_STAGE_A(bufoff, offn[h], kb); else PG8_STAGE_A(bufoff, offc[h], kb); } while (0)
            const char* b2 = last ? nB : cB + (size_t)(t + 2) * kstep; const char* b3 = b2 + kstep;
            PG8_LDB(B0, 0, 0); PG8_LDB(B1, 0, 1); PG8_SCHED; PG8_LDA(At, 0, 0); PG8_STAGE_A(PG8_SA(1, 1), offc[1], kb1);
            PG8_WAIT_V(8); PG8_WAIT_L(0); PG8_BAR; PG8_MMA(0, 0, At, B0); PG8_MMA(0, 1, At, B1); PG8_BAR; PG8_SCHED;
            PG8_LDA(At, 0, 1); PG8_STAGE_B(PG8_SB(0, 0), b2); PG8_STAGE_B(PG8_SB(0, 1), b2 + hstep); PG8_STAGE_A2(PG8_SA(0, 0), 0, kb2);
            PG8_WAIT_V(8); PG8_WAIT_L(0); PG8_BAR; PG8_MMA(1, 0, At, B0); PG8_MMA(1, 1, At, B1); PG8_BAR; PG8_SCHED;
            PG8_LDB(B0, 1, 0); PG8_LDB(B1, 1, 1); PG8_SCHED; PG8_LDA(At, 1, 0); PG8_STAGE_A2(PG8_SA(0, 1), 1, kb2);
            PG8_WAIT_V(8); PG8_WAIT_L(0); PG8_BAR; PG8_MMA(0, 0, At, B0); PG8_MMA(0, 1, At, B1); PG8_BAR; PG8_SCHED;
            PG8_LDA(At, 1, 1); PG8_STAGE_B(PG8_SB(1, 0), b3); PG8_STAGE_B(PG8_SB(1, 1), b3 + hstep); PG8_STAGE_A2(PG8_SA(1, 0), 0, kb3);
            PG8_WAIT_V(8); PG8_WAIT_L(0); PG8_BAR; PG8_MMA(1, 0, At, B0); PG8_MMA(1, 1, At, B1); PG8_BAR; PG8_SCHED;
        }
        const bool has_nn = has_next && S.next(ui + 2, nn);
#pragma unroll
        for (int h = 0; h < 2; ++h)
#pragma unroll
            for (int i = 0; i < 2; ++i) offc[h][i] = offn[h][i];
        unsigned rawn[2][2];
        if (has_nn) { if constexpr (RowMap::LOADS) PG8_ARAW(rawn, nn); else PG8_AOFF(offn, nn); }
        if (wr == 0) PG8_BAR;
        E(acc, cur, wr, wc, fr, fq);
        if constexpr (RowMap::LOADS) { if (has_nn) PG8_AFIN(offn, rawn); PG8_WAIT_V(0); PG8_WAIT_L(0); }
        if (!has_next) break;
#pragma unroll
        for (int a = 0; a < 2; ++a)
#pragma unroll
            for (int b = 0; b < 2; ++b)
#pragma unroll
                for (int m = 0; m < 4; ++m)
#pragma unroll
                    for (int n = 0; n < 2; ++n) acc[a][b][m][n] = (f32x4){0.f, 0.f, 0.f, 0.f};
        cur = nxt; cB = nB; nxt = nn; has_next = has_nn; ++ui;
        if (wr == 1) PG8_BAR;
    }
    PG8_WAIT_V(0);
    PG8_BAR;
#undef PG8_SA
#undef PG8_SB
#undef PG8_STAGE_A
#undef PG8_STAGE_A2
#undef PG8_STAGE_B
#undef PG8_LDA
#undef PG8_LDB
#undef PG8_MMA
#undef PG8_CAT
#undef PG8_WAIT_V
#undef PG8_WAIT_L
#undef PG8_BAR
#undef PG8_SCHED
#undef PG8_AOFF
#undef PG8_ARAW
#undef PG8_AFIN
}
}

namespace att {
constexpr int NW = 8, QBLK = 32, KVBLK = 64, LD = DM;
constexpr float THRL = 8.f;
#define KSWZ64(row, colB) ((row) * 128 + ((colB) ^ ((((row) >> 1) & 7) << 4)))
#define SBAR() __builtin_amdgcn_sched_barrier(0)
__device__ __forceinline__ int crow(int r, int hi) { return (r & 3) + 8 * (r >> 2) + 4 * hi; }
template <int NCB> __device__ __forceinline__ int v_st(int k, int c) { const int kk = (k & ~0xC) | ((k & 4) << 1) | ((k & 8) >> 1); return ((kk >> 3) * NCB + (c >> 5)) * 512 + ((kk & 7) * 32 + (c & 31)) * 2; }
__device__ __forceinline__ int v_rd_base(int lane) { return ((lane & 3) << 3) | (((lane >> 2) & 3) << 6) | (((lane >> 4) & 1) << 5) | (((lane >> 5) & 1) << 8); }
template <int OFF> __device__ __forceinline__ s16x4 tr_read(int vb) { s16x4 r; asm volatile("ds_read_b64_tr_b16 %0, %1 offset:%2" : "=&v"(r) : "v"(vb), "i"(OFF) : "memory"); return r; }
template <int NCB, int D0> __device__ __forceinline__ void pv_one(f32x16& od, int vb, bf16x8 pa0, bf16x8 pa1, bf16x8 pa2, bf16x8 pa3) {
    constexpr int G = NCB * 512;
    const s16x4 l0 = tr_read<D0 * 512 + 0 * G>(vb), h0 = tr_read<D0 * 512 + 1 * G>(vb), l1 = tr_read<D0 * 512 + 2 * G>(vb), h1 = tr_read<D0 * 512 + 3 * G>(vb);
    const s16x4 l2 = tr_read<D0 * 512 + 4 * G>(vb), h2 = tr_read<D0 * 512 + 5 * G>(vb), l3 = tr_read<D0 * 512 + 6 * G>(vb), h3 = tr_read<D0 * 512 + 7 * G>(vb);
    asm volatile("s_waitcnt lgkmcnt(0)" ::: "memory"); SBAR();
#define PK(L, H) (bf16x8){L[0], L[1], L[2], L[3], H[0], H[1], H[2], H[3]}
    od = __builtin_amdgcn_mfma_f32_32x32x16_bf16(pa0, PK(l0, h0), od, 0, 0, 0);
    od = __builtin_amdgcn_mfma_f32_32x32x16_bf16(pa1, PK(l1, h1), od, 0, 0, 0);
    od = __builtin_amdgcn_mfma_f32_32x32x16_bf16(pa2, PK(l2, h2), od, 0, 0, 0);
    od = __builtin_amdgcn_mfma_f32_32x32x16_bf16(pa3, PK(l3, h3), od, 0, 0, 0);
#undef PK
}
template <int DV> struct Lay { static constexpr int NCB = DV / 32, SHM_K = 8192, SHM_V = 64 * DV * 2, OFF_V = 2 * SHM_K, OFF_WS = OFF_V + 2 * SHM_V, OFF_BIAS = OFF_WS + NW * 256, END = OFF_BIAS + 2048; };

template <int DV, bool NA, class BG>
__device__ __forceinline__ void attn_run(f32x16 (&o)[DV / 32], const bf16_t* Qw, const bf16_t* Kh, const bf16_t* Vh, int row_first, int n_main, int ctx_row, int n_ctx,
                                         char* lds, int jlo, int drbase, int qcol, BG& bg  ) {
    using L = Lay<DV>; constexpr int NCB = L::NCB;
    int tid = threadIdx.x; asm volatile("" : "+v"(tid));
    const int wid = __builtin_amdgcn_readfirstlane(tid >> 6), lane = tid & 63, r32 = lane & 31, hi = lane >> 5;
    char* K_lds = lds; char* V_lds = lds + L::OFF_V;
    float* wsf = (float*)(lds + L::OFF_WS) + wid * 64; const float* bias_l = (const float*)(lds + L::OFF_BIAS);
    float m_reg = 0.f, l_reg = 0.f; bool first = true; f32x16 negm = f32x16{};
#pragma unroll
    for (int d = 0; d < NCB; ++d) o[d] = f32x16{};
    bf16x8 qr[4];
#pragma unroll
    for (int d0 = 0; d0 < 4; ++d0) qr[d0] = *reinterpret_cast<const bf16x8*>(Qw + (size_t)r32 * LD + d0 * 16 + hi * 8);
    const int ksr = tid >> 3, ksc = (tid & 7) * 8;
    const int vsr = (DV == 128) ? (tid >> 4) : (tid >> 3), vsc = (DV == 128) ? (tid & 15) * 8 : (tid & 7) * 8;
    const int vst0 = v_st<NCB>(vsr, vsc), vst1 = v_st<NCB>(32 + vsr, vsc);
    const int vb0 = (int)(uintptr_t)V_lds + v_rd_base(lane);
    const int NT = n_main + n_ctx;
    bf16x8 ksA, vsA0, vsA1, ksB, vsB0, vsB1;
#define TROW(j) ((j) < n_main ? row_first + (j) * KVBLK : ctx_row + ((j) - n_main) * KVBLK)
#define SLOAD(j, KS, VS0, VS1) do { const size_t r_ = (size_t)TROW(j); KS = *reinterpret_cast<const bf16x8*>(Kh + (r_ + ksr) * LD + ksc); \
        VS0 = *reinterpret_cast<const bf16x8*>(Vh + (r_ + vsr) * LD + vsc); if (DV == 128) VS1 = *reinterpret_cast<const bf16x8*>(Vh + (r_ + 32 + vsr) * LD + vsc); } while (0)
#define SWRITE(b, KS, VS0, VS1) do { *(bf16x8*)(K_lds + (b) * L::SHM_K + KSWZ64(ksr, ksc * 2)) = KS; *(bf16x8*)(V_lds + (b) * L::SHM_V + vst0) = VS0; \
        if (DV == 128) *(bf16x8*)(V_lds + (b) * L::SHM_V + vst1) = VS1; } while (0)
    auto compute = [&](const int j, const int b) __attribute__((always_inline)) {
        const bool part = NA ? (j >= n_main || (j >= jlo && j < jlo + 8)) : true;
        if (part) {
            f32x16 p0 = negm, p1 = negm;
            const char* Kb = K_lds + b * L::SHM_K;
#pragma unroll
            for (int d0 = 0; d0 < 4; ++d0) { const int cb = (d0 * 16 + hi * 8) * 2;
                const bf16x8 b0 = *reinterpret_cast<const bf16x8*>(Kb + KSWZ64(r32, cb));
                const bf16x8 b1 = *reinterpret_cast<const bf16x8*>(Kb + KSWZ64(32 + r32, cb));
                p0 = __builtin_amdgcn_mfma_f32_32x32x16_bf16(b0, qr[d0], p0, 0, 0, 0);
                p1 = __builtin_amdgcn_mfma_f32_32x32x16_bf16(b1, qr[d0], p1, 0, 0, 0); }
            if (NA && j < n_main) {
                const int c0 = min(max(qcol - 8, 0), GRIDW - 16), dr = drbase + j, sh = 15 - qcol;
                const LAS float* brow = (const LAS float*)(uintptr_t)(unsigned)(uintptr_t)bias_l + dr * 32;
                float bv0[16], bv1[16];
#pragma unroll
                for (int r = 0; r < 16; ++r) { const int cc = crow(r, hi), c2 = cc + 32;
                    const int i0 = ((unsigned)(cc - c0) < 16u) ? cc + sh : 31, i1 = ((unsigned)(c2 - c0) < 16u) ? c2 + sh : 31;
                    bv0[r] = brow[i0]; bv1[r] = brow[i1]; }
#pragma unroll
                for (int r = 0; r < 16; ++r) { p0[r] += bv0[r]; p1[r] += bv1[r]; }
            }
            float pmax = p0[0];
#pragma unroll
            for (int r = 1; r < 16; ++r) pmax = fmaxf(pmax, p0[r]);
#pragma unroll
            for (int r = 0; r < 16; ++r) pmax = fmaxf(pmax, p1[r]);
            { auto rr = __builtin_amdgcn_permlane32_swap(__float_as_uint(pmax), __float_as_uint(pmax), false, false); pmax = fmaxf(__uint_as_float(rr[0]), __uint_as_float(rr[1])); }
            float alpha = 1.f;
            if (first || !__all(pmax <= THRL)) { const float dl = first ? pmax : fmaxf(pmax, 0.f); if (!first) alpha = __builtin_amdgcn_exp2f(-dl); m_reg += dl; first = false;
#pragma unroll
                for (int r = 0; r < 16; ++r) { p0[r] -= dl; p1[r] -= dl; }
#pragma unroll
                for (int r = 0; r < 16; ++r) negm[r] = -m_reg;
                asm volatile("" : "+v"(negm)); }
#pragma unroll
            for (int r = 0; r < 16; ++r) { p0[r] = __builtin_amdgcn_exp2f(p0[r]); p1[r] = __builtin_amdgcn_exp2f(p1[r]); }
            float ps = 0.f;
#pragma unroll
            for (int r = 0; r < 16; ++r) ps += p0[r];
#pragma unroll
            for (int r = 0; r < 16; ++r) ps += p1[r];
            { auto rr = __builtin_amdgcn_permlane32_swap(__float_as_uint(ps), __float_as_uint(ps), false, false); ps = __uint_as_float(rr[0]) + __uint_as_float(rr[1]); }
            l_reg = l_reg * alpha + ps;
            bf16x8 pa0, pa1, pa2, pa3;
#define PK4(P, BASE, OUT) do { unsigned a0 = cvt_pk_bf16(P[BASE + 0], P[BASE + 1]), a1 = cvt_pk_bf16(P[BASE + 2], P[BASE + 3]);   \
    unsigned b0_ = cvt_pk_bf16(P[BASE + 4], P[BASE + 5]), b1_ = cvt_pk_bf16(P[BASE + 6], P[BASE + 7]);                              \
    auto r0 = __builtin_amdgcn_permlane32_swap(a0, b0_, false, false); auto r1 = __builtin_amdgcn_permlane32_swap(a1, b1_, false, false); \
    u32x4 w = {r0[0], r1[0], r0[1], r1[1]}; OUT = *reinterpret_cast<bf16x8*>(&w); } while (0)
            PK4(p0, 0, pa0); PK4(p0, 8, pa1); PK4(p1, 0, pa2); PK4(p1, 8, pa3);
#undef PK4
            if (__any(alpha < 1.f)) { if (hi == 0) wsf[r32] = alpha; asm volatile("s_waitcnt lgkmcnt(0)" ::: "memory");
#pragma unroll
                for (int d = 0; d < NCB; ++d)
#pragma unroll
                    for (int r = 0; r < 16; ++r) o[d][r] *= wsf[crow(r, hi)];
                asm volatile("s_waitcnt lgkmcnt(0)" ::: "memory"); }
            const int vb = vb0 + b * L::SHM_V;
            pv_one<NCB, 0>(o[0], vb, pa0, pa1, pa2, pa3); pv_one<NCB, 1>(o[1], vb, pa0, pa1, pa2, pa3);
            if constexpr (NCB == 4) { pv_one<NCB, 2>(o[2], vb, pa0, pa1, pa2, pa3); pv_one<NCB, 3>(o[3], vb, pa0, pa1, pa2, pa3); }
        }
    };
    SLOAD(0, ksA, vsA0, vsA1);
    if (NT > 1) SLOAD(1, ksB, vsB0, vsB1);
    for (int j = 0; j < NT; j += 2) {
        SWRITE(0, ksA, vsA0, vsA1);
        if (j + 2 < NT) SLOAD(j + 2, ksA, vsA0, vsA1);
        __syncthreads();
        compute(j, 0);
        if (j + 1 < NT) {
            SWRITE(1, ksB, vsB0, vsB1);
            if (j + 3 < NT) SLOAD(j + 3, ksB, vsB0, vsB1);
            __syncthreads();
            bg.step();
            compute(j + 1, 1);
        }
    }
    if (hi == 0) wsf[32 + r32] = l_reg; asm volatile("s_waitcnt lgkmcnt(0)" ::: "memory");
#pragma unroll
    for (int r = 0; r < 16; ++r) { const float rl = __builtin_amdgcn_rcpf(wsf[32 + crow(r, hi)]);
#pragma unroll
        for (int d = 0; d < NCB; ++d) o[d][r] *= rl; }
    __syncthreads();
#undef TROW
#undef SLOAD
#undef SWRITE
}

constexpr int DA_KS = 4096, DA_VS = 8192, DA_OFF_V = 4 * DA_KS, DA_OFF_WS = DA_OFF_V + 4 * DA_VS, DA_END = DA_OFF_WS + NW * 256;
constexpr float DA_POFF = 6.f, DA_PLIM = 8.f;
typedef int v8i_t __attribute__((ext_vector_type(8)));
#define DA_WAITBAR(N) asm volatile("s_waitcnt vmcnt(" #N ") lgkmcnt(0)\n\ts_barrier" ::: "memory")
#define DA_LGKM(N) asm volatile("s_waitcnt lgkmcnt(" #N ")" ::: "memory")
template <int ABL>
__device__ __forceinline__ void dattn_run(f32x16 (&o)[4], const unsigned char* Qw8, const unsigned char* Kh8, const unsigned char* Vt8, int row_first, int ctx_row, char* lds) {
    constexpr int NT = SEQ / 64 + CTXL / 64, NMAIN = SEQ / 64;
    int tid = threadIdx.x; asm volatile("" : "+v"(tid));
    const int wid = __builtin_amdgcn_readfirstlane(tid >> 6), lane = tid & 63, r32 = lane & 31, hi = lane >> 5;
    const bool kw = wid < 4;
    LAS unsigned char* ldsl = (LAS unsigned char*)(uintptr_t)(unsigned)(uintptr_t)lds;
    float* wsf = (float*)(lds + DA_OFF_WS) + wid * 64;
    unsigned koff;
    { const int p = (wid & 3) * 64 + lane, key = p >> 2, c = (p & 3) ^ ((key >> 2) & 3); koff = (unsigned)(key * LD + c * 16); }
    const unsigned voff = (unsigned)(wid * 64 + lane) * 16u;
#define DA_TROW(t) ((t) < NMAIN ? row_first + (t) * 64 : ctx_row + ((t) - NMAIN) * 64)
#define DA_DMA_K(t, slot) do { if (kw) { const char* g_ = (const char*)Kh8 + (size_t)DA_TROW(t) * LD; \
        __builtin_amdgcn_global_load_lds((const unsigned*)(g_ + koff), (LAS unsigned*)(ldsl + (slot) * DA_KS + (wid & 3) * 1024), 16, 0, 0); } } while (0)
#define DA_DMA_V(t, slot) do { if (kw) { const char* g_ = (const char*)Vt8 + (size_t)(t) * 8192;     \
        __builtin_amdgcn_global_load_lds((const unsigned*)(g_ + voff), (LAS unsigned*)(ldsl + DA_OFF_V + (slot) * DA_VS + wid * 1024), 16, 0, 0); \
        __builtin_amdgcn_global_load_lds((const unsigned*)(g_ + voff + 4096), (LAS unsigned*)(ldsl + DA_OFF_V + (slot) * DA_VS + wid * 1024 + 4096), 16, 0, 0); } } while (0)
#define DA_WB_STEADY() do { if (kw) DA_WAITBAR(3); else DA_WAITBAR(0); } while (0)
    v8i_t qf;
    { const u32x4 a = *reinterpret_cast<const u32x4*>(Qw8 + (size_t)r32 * LD + hi * 32), b = *reinterpret_cast<const u32x4*>(Qw8 + (size_t)r32 * LD + hi * 32 + 16);
      qf = (v8i_t){(int)a[0], (int)a[1], (int)a[2], (int)a[3], (int)b[0], (int)b[1], (int)b[2], (int)b[3]}; }
    DA_DMA_K(0, 0); DA_DMA_V(0, 0); DA_DMA_K(1, 1); DA_DMA_K(2, 2); DA_DMA_V(1, 1);
    float m_reg = 0.f; f32x16 ol = f32x16{};
#pragma unroll
    for (int d = 0; d < 4; ++d) o[d] = f32x16{};
    const int vsw = (r32 >> 2) & 3;
    const int kb0 = (int)(uintptr_t)lds + r32 * 64 + ((2 * hi) ^ vsw) * 16;
    const int vb0 = (int)(uintptr_t)(lds + DA_OFF_V) + r32 * 64 + ((2 * hi) ^ vsw) * 16, vb1x = 16 - 32 * (((2 * hi) ^ vsw) & 1);
    f32x16 pA0, pA1, pB0, pB1, negm = f32x16{};
    v8i_t pk = (v8i_t){0, 0, 0, 0, 0, 0, 0, 0};
    u32x4 kfa_[2], kfb_[2]; u32x4 vfa_[3], vfb_[3];
    v8i_t ones8; { int o1 = 0x38383838; asm volatile("" : "+s"(o1)); ones8 = (v8i_t){o1, o1, o1, o1, o1, o1, o1, o1}; asm volatile("" : "+v"(ones8)); }
    const int scl1 = 0x7f7f7f7f, sclq = 0x7c7c7c7c;
#define DA_KRD(dst, addr, OFF) asm volatile("ds_read_b128 %0, %1 offset:%2" : "=&v"(dst) : "v"(addr), "i"(OFF) : "memory")
#define DA_KFR(g, ka) do { DA_KRD(kfa_[g], ka, (g) * 2048); DA_KRD(kfb_[g], (ka) + vb1x, (g) * 2048); } while (0)
#define DA_KF8(g) (v8i_t){(int)kfa_[g][0], (int)kfa_[g][1], (int)kfa_[g][2], (int)kfa_[g][3], (int)kfb_[g][0], (int)kfb_[g][1], (int)kfb_[g][2], (int)kfb_[g][3]}
#define DA_QKM(g) __builtin_amdgcn_mfma_scale_f32_32x32x64_f8f6f4(DA_KF8(g), qf, negm, 0, 0, 0, 0, 0, 0)
#define DA_VFR(s, d, vb) do { DA_KRD(vfa_[s], vb, (d) * 2048); DA_KRD(vfb_[s], (vb) + vb1x, (d) * 2048); } while (0)
#define DA_VF8(s) (v8i_t){(int)vfa_[s][0], (int)vfa_[s][1], (int)vfa_[s][2], (int)vfa_[s][3], (int)vfb_[s][0], (int)vfb_[s][1], (int)vfb_[s][2], (int)vfb_[s][3]}
#define DA_PVM(d, s) o[d] = __builtin_amdgcn_mfma_scale_f32_32x32x64_f8f6f4(pk, DA_VF8(s), o[d], 0, 0, 0, 0, 0, 0)
#define DA_C4(P, B, OLD) ({ int t_ = __builtin_amdgcn_cvt_pk_fp8_f32(P[B], P[B + 1], (OLD), false); t_ = __builtin_amdgcn_cvt_pk_fp8_f32(P[B + 2], P[B + 3], t_, true); t_; })
#define DA_ADD4(S, P, B) do { S += P[B]; S += P[B + 1]; S += P[B + 2]; S += P[B + 3]; } while (0)
#define DA_EX(P, r) P[r] = __builtin_amdgcn_exp2f(P[r])
#define DA_PIN(x) asm volatile("" : "+v"(x))
#define DA_SUB16(P, D) asm volatile("v_sub_f32 %0, %0, %16\n\tv_sub_f32 %1, %1, %16\n\tv_sub_f32 %2, %2, %16\n\tv_sub_f32 %3, %3, %16\n\tv_sub_f32 %4, %4, %16\n\tv_sub_f32 %5, %5, %16\n\tv_sub_f32 %6, %6, %16\n\tv_sub_f32 %7, %7, %16\n\t" \
        "v_sub_f32 %8, %8, %16\n\tv_sub_f32 %9, %9, %16\n\tv_sub_f32 %10, %10, %16\n\tv_sub_f32 %11, %11, %16\n\tv_sub_f32 %12, %12, %16\n\tv_sub_f32 %13, %13, %16\n\tv_sub_f32 %14, %14, %16\n\tv_sub_f32 %15, %15, %16" \
        : "+v"(P[0]), "+v"(P[1]), "+v"(P[2]), "+v"(P[3]), "+v"(P[4]), "+v"(P[5]), "+v"(P[6]), "+v"(P[7]), "+v"(P[8]), "+v"(P[9]), "+v"(P[10]), "+v"(P[11]), "+v"(P[12]), "+v"(P[13]), "+v"(P[14]), "+v"(P[15]) : "v"(D))
#define DA_AMX(M, A_, B_) asm volatile("v_max3_f32 %0, %0, %1, %2" : "+v"(M) : "v"(A_), "v"(B_))
#define DA_MX4(M, P, B) do { M = fmaxf(fmaxf(M, P[B]), P[B + 1]); M = fmaxf(fmaxf(M, P[B + 2]), P[B + 3]); } while (0)
#define DA_PA(X0, X1, Y0, Y1, ks, vs) do { \
        const int ka_ = kb0 + (ks) * DA_KS, vb_ = vb0 + (vs) * DA_VS; \
        DA_KFR(0, ka_); DA_KFR(1, ka_); \
        pk[0] = DA_C4(Y0, 0, pk[0]); pk[1] = DA_C4(Y0, 4, pk[1]); \
        DA_LGKM(2); SBAR(); \
        X0 = DA_QKM(0); DA_VFR(0, 0, vb_); pk[2] = DA_C4(Y0, 8, pk[2]); pk[3] = DA_C4(Y0, 12, pk[3]); SBAR(); \
        DA_LGKM(2); SBAR(); \
        X1 = DA_QKM(1); pk[4] = DA_C4(Y1, 0, pk[4]); pk[5] = DA_C4(Y1, 4, pk[5]); pk[6] = DA_C4(Y1, 8, pk[6]); pk[7] = DA_C4(Y1, 12, pk[7]); DA_PIN(pk); DA_VFR(1, 1, vb_); SBAR();     \
        ol = __builtin_amdgcn_mfma_scale_f32_32x32x64_f8f6f4(pk, ones8, ol, 0, 0, 0, 0, 0, 0); SBAR(); } while (0)
#define DA_PB(X0, X1, vs) do { float ALX; bool RS_; const int vb_ = vb0 + (vs) * DA_VS; \
        DA_LGKM(2); SBAR(); DA_PVM(0, 0); DA_VFR(2, 2, vb_); SBAR(); \
        float mx_;                                                  \
        asm volatile("v_max3_f32 %0, %1, %2, %3\n\tv_max3_f32 %0, %0, %4, %5\n\tv_max3_f32 %0, %0, %6, %7\n\tv_max3_f32 %0, %0, %8, %9\n\tv_max3_f32 %0, %0, %10, %11\n\tv_max3_f32 %0, %0, %12, %13\n\tv_max3_f32 %0, %0, %14, %15\n\tv_max_f32 %0, %0, %16" \
            : "=&v"(mx_) : "v"(X0[0]), "v"(X0[1]), "v"(X0[2]), "v"(X0[3]), "v"(X0[4]), "v"(X0[5]), "v"(X0[6]), "v"(X0[7]), "v"(X0[8]), "v"(X0[9]), "v"(X0[10]), "v"(X0[11]), "v"(X0[12]), "v"(X0[13]), "v"(X0[14]), "v"(X0[15])); \
        { float t_;                                                 \
        asm volatile("v_max3_f32 %0, %0, %2, %3\n\tv_max3_f32 %0, %0, %4, %5\n\tv_max3_f32 %0, %0, %6, %7\n\tv_max3_f32 %0, %0, %8, %9\n\tv_max3_f32 %0, %0, %10, %11\n\tv_max3_f32 %0, %0, %12, %13\n\tv_max3_f32 %0, %0, %14, %15\n\tv_max3_f32 %0, %0, %16, %17\n\t" \
                     "v_mov_b32 %1, %0\n\ts_nop 1\n\tv_permlane32_swap_b32 %0, %1\n\tv_max_f32 %0, %0, %1" \
            : "+v"(mx_), "=&v"(t_) : "v"(X1[0]), "v"(X1[1]), "v"(X1[2]), "v"(X1[3]), "v"(X1[4]), "v"(X1[5]), "v"(X1[6]), "v"(X1[7]), "v"(X1[8]), "v"(X1[9]), "v"(X1[10]), "v"(X1[11]), "v"(X1[12]), "v"(X1[13]), "v"(X1[14]), "v"(X1[15])); } \
            { \
              ALX = 1.f; RS_ = !__all(mx_ <= DA_PLIM); if (RS_) { const float dl = fmaxf(mx_ - DA_POFF, 0.f); ALX = __builtin_amdgcn_exp2f(-dl); m_reg += dl; \
                  _Pragma("unroll") for (int r = 0; r < 16; ++r) { X0[r] -= dl; asm volatile("" : "+v"(X0[r])); X1[r] -= dl; asm volatile("" : "+v"(X1[r])); }     \
                  _Pragma("unroll") for (int r = 0; r < 16; ++r) negm[r] = -m_reg; asm volatile("" : "+v"(negm)); } } SBAR(); \
        DA_LGKM(2); SBAR(); DA_PVM(1, 1); DA_VFR(0, 3, vb_); DA_EX(X0, 0); DA_EX(X0, 1); DA_EX(X0, 2); DA_EX(X0, 3); DA_EX(X0, 4); DA_EX(X0, 5); DA_EX(X0, 6); DA_EX(X0, 7); DA_EX(X0, 8); DA_EX(X0, 9); DA_EX(X0, 10); DA_PIN(X0); SBAR(); \
        DA_LGKM(2); SBAR(); DA_PVM(2, 2); DA_EX(X0, 11); DA_EX(X0, 12); DA_EX(X0, 13); DA_EX(X0, 14); DA_EX(X0, 15); DA_EX(X1, 0); DA_EX(X1, 1); DA_EX(X1, 2); DA_EX(X1, 3); DA_EX(X1, 4); DA_EX(X1, 5); DA_PIN(X0); DA_PIN(X1); SBAR(); \
        DA_LGKM(0); SBAR(); DA_PVM(3, 0); DA_EX(X1, 6); DA_EX(X1, 7); DA_EX(X1, 8); DA_EX(X1, 9); DA_EX(X1, 10); DA_EX(X1, 11); DA_EX(X1, 12); DA_EX(X1, 13); DA_EX(X1, 14); DA_EX(X1, 15); DA_PIN(X1); SBAR(); \
        if (RS_) { if (hi == 0) wsf[r32] = (ALX); asm volatile("s_waitcnt lgkmcnt(0)" ::: "memory"); \
            _Pragma("unroll") for (int r = 0; r < 16; ++r) { const float a_ = wsf[crow(r, hi)]; ol[r] *= a_; _Pragma("unroll") for (int d = 0; d < 4; ++d) o[d][r] *= a_; } } \
    } while (0)
#define DA_NEXT3(x) (((x) == 2) ? 0 : (x) + 1)
#define DA_PREV3(x) (((x) == 0) ? 2 : (x) - 1)
#define DA_A0() do { DA_KFR(0, kb0); DA_KFR(1, kb0); DA_LGKM(0); SBAR(); pA0 = DA_QKM(0); pA1 = DA_QKM(1); SBAR(); } while (0)
#define DA_B0() do { float mx_ = pA0[0]; \
      _Pragma("unroll") for (int r = 1; r < 16; ++r) mx_ = fmaxf(mx_, pA0[r]); \
      _Pragma("unroll") for (int r = 0; r < 16; ++r) mx_ = fmaxf(mx_, pA1[r]); \
      { auto rr = __builtin_amdgcn_permlane32_swap(__float_as_uint(mx_), __float_as_uint(mx_), false, false); mx_ = fmaxf(__uint_as_float(rr[0]), __uint_as_float(rr[1])); } \
      m_reg = mx_ - DA_POFF; \
      _Pragma("unroll") for (int r = 0; r < 16; ++r) { pA0[r] -= m_reg; pA1[r] -= m_reg; negm[r] = -m_reg; } \
      asm volatile("" : "+v"(negm)); \
      _Pragma("unroll") for (int r = 0; r < 16; ++r) { DA_EX(pA0, r); DA_EX(pA1, r); } } while (0)
#define DA_DRAIN() do { \
      pk[0] = DA_C4(pB0, 0, pk[0]); pk[1] = DA_C4(pB0, 4, pk[1]); pk[2] = DA_C4(pB0, 8, pk[2]); pk[3] = DA_C4(pB0, 12, pk[3]); pk[4] = DA_C4(pB1, 0, pk[4]); pk[5] = DA_C4(pB1, 4, pk[5]); pk[6] = DA_C4(pB1, 8, pk[6]); pk[7] = DA_C4(pB1, 12, pk[7]); \
      const int vb_ = vb0 + ((NT - 1) & 3) * DA_VS; \
      ol = __builtin_amdgcn_mfma_scale_f32_32x32x64_f8f6f4(pk, ones8, ol, 0, 0, 0, 0, 0, 0); \
      DA_VFR(0, 0, vb_); DA_VFR(1, 1, vb_); DA_VFR(2, 2, vb_); DA_LGKM(4); SBAR(); DA_PVM(0, 0); SBAR(); DA_LGKM(2); SBAR(); DA_PVM(1, 1); SBAR(); \
      asm volatile("s_nop 7\n\ts_nop 7" ::: "memory"); DA_VFR(0, 3, vb_); DA_LGKM(2); SBAR(); DA_PVM(2, 2); SBAR(); DA_LGKM(0); SBAR(); DA_PVM(3, 0); SBAR(); } while (0)
    static_assert(NT == 260, "the unrolled loops and their tails are written for 260 tiles");
    DA_WB_STEADY();
    if (kw) {
        DA_A0(); DA_B0();
        DA_WAITBAR(3);
        for (int j = 1; j + 6 < NT; j += 4) {
            DA_DMA_K(j + 2, 3); DA_DMA_V(j + 1, 2);
            DA_PA(pB0, pB1, pA0, pA1, 1, 0); DA_PB(pB0, pB1, 0); DA_WAITBAR(3);
            DA_DMA_K(j + 3, 0); DA_DMA_V(j + 2, 3);
            DA_PA(pA0, pA1, pB0, pB1, 2, 1); DA_PB(pA0, pA1, 1); DA_WAITBAR(3);
            DA_DMA_K(j + 4, 1); DA_DMA_V(j + 3, 0);
            DA_PA(pB0, pB1, pA0, pA1, 3, 2); DA_PB(pB0, pB1, 2); DA_WAITBAR(3);
            DA_DMA_K(j + 5, 2); DA_DMA_V(j + 4, 1);
            DA_PA(pA0, pA1, pB0, pB1, 0, 3); DA_PB(pA0, pA1, 3); DA_WAITBAR(3);
        }
        DA_DMA_K(259, 3); DA_DMA_V(258, 2);
        DA_PA(pB0, pB1, pA0, pA1, 1, 0); DA_PB(pB0, pB1, 0); DA_WAITBAR(3);
        DA_DMA_V(259, 3);
        DA_PA(pA0, pA1, pB0, pB1, 2, 1); DA_PB(pA0, pA1, 1); DA_WAITBAR(0);
        DA_PA(pB0, pB1, pA0, pA1, 3, 2); DA_PB(pB0, pB1, 2); DA_WAITBAR(0);
        DA_DRAIN();
    } else {
        DA_A0();
        DA_WAITBAR(0);
        DA_DMA_V(2, 2);
        DA_B0(); DA_PA(pB0, pB1, pA0, pA1, 1, 0); DA_WAITBAR(0);
        for (int j = 2; j + 5 < NT; j += 4) {
            DA_DMA_V(j + 1, 3);
            DA_PB(pB0, pB1, 0); DA_PA(pA0, pA1, pB0, pB1, 2, 1); DA_WAITBAR(0);
            DA_DMA_V(j + 2, 0);
            DA_PB(pA0, pA1, 1); DA_PA(pB0, pB1, pA0, pA1, 3, 2); DA_WAITBAR(0);
            DA_DMA_V(j + 3, 1);
            DA_PB(pB0, pB1, 2); DA_PA(pA0, pA1, pB0, pB1, 0, 3); DA_WAITBAR(0);
            DA_DMA_V(j + 4, 2);
            DA_PB(pA0, pA1, 3); DA_PA(pB0, pB1, pA0, pA1, 1, 0); DA_WAITBAR(0);
        }
        DA_DMA_V(259, 3);
        DA_PB(pB0, pB1, 0); DA_PA(pA0, pA1, pB0, pB1, 2, 1); DA_WAITBAR(0);
        DA_PB(pA0, pA1, 1); DA_PA(pB0, pB1, pA0, pA1, 3, 2); DA_WAITBAR(0);
        DA_PB(pB0, pB1, 2);
        DA_DRAIN();
    }
#pragma unroll
    for (int r = 0; r < 16; ++r) { const float rl = __builtin_amdgcn_rcpf(ol[r]);
#pragma unroll
        for (int d = 0; d < 4; ++d) o[d][r] *= rl; }
    DA_WAITBAR(0);
#undef DA_TROW
#undef DA_DMA_K
#undef DA_DMA_V
#undef DA_WB_STEADY
#undef DA_KRD
#undef DA_KFR
#undef DA_KF8
#undef DA_QKM
#undef DA_VFR
#undef DA_VF8
#undef DA_PVM
#undef DA_C4
#undef DA_ADD4
#undef DA_EX
#undef DA_PIN
#undef DA_MX4
#undef DA_AMX
#undef DA_SUB16
#undef DA_PA
#undef DA_PB
#undef DA_A0
#undef DA_B0
#undef DA_DRAIN
#undef DA_NEXT3
#undef DA_PREV3
}
#undef SBAR
}

typedef GAS unsigned gu32;
#define RLX_AGENT __ATOMIC_RELAXED, __HIP_MEMORY_SCOPE_AGENT
#define XB_TMO      128
#define XB_XCNT(j)  (256  + 64 * (j))
#define XB_XSUB(j)  (1280 + 64 * (j))
#define XB_XGEN(j)  (2304 + 64 * (j))
#define XB_TOP      3328
#define XB_TOPGEN   3392
#define XCD_BAR_WORDS 3456
#define XB_SPIN_CAP (1u << 20)
__device__ __forceinline__ unsigned xb_ld(unsigned* p)              { return __hip_atomic_load(p, __ATOMIC_RELAXED, __HIP_MEMORY_SCOPE_AGENT); }
__device__ __forceinline__ unsigned xb_add(unsigned* p, unsigned v) { return __hip_atomic_fetch_add(p, v, __ATOMIC_RELAXED, __HIP_MEMORY_SCOPE_AGENT); }
__device__ __forceinline__ unsigned xb_xcc_id() { return (unsigned)__builtin_amdgcn_s_getreg((3 << 11) | 20) & 0xFu; }
#define XB_SPIN(cond, bar) do { unsigned _sp = 0; while (cond) { __builtin_amdgcn_s_sleep(1); \
    if ((++_sp & 255u) == 0u) { if (xb_ld(&(bar)[XB_TMO])) break; if (_sp > XB_SPIN_CAP) { atomicAdd(&(bar)[XB_TMO], 1u); break; } } } } while (0)
struct XcdBarrier { unsigned* bar; unsigned x; volatile LAS unsigned* st; };
__device__ __forceinline__ XcdBarrier xcd_barrier_post(unsigned* bar, volatile LAS unsigned* st) {
    XcdBarrier b; b.bar = bar; b.x = xb_xcc_id(); b.st = st;
    if (threadIdx.x == 0) (void)xb_add(&bar[XB_XCNT(b.x)], 1u);
    return b;
}
__device__ __forceinline__ void xcd_barrier_complete(unsigned* bar, unsigned x, unsigned& nloc, unsigned& nx) {
    const unsigned G = gridDim.x * gridDim.y * gridDim.z;
    unsigned sum, cnt, mine, sp = 0u;
    for (;;) {
        sum = 0u; cnt = 0u; mine = 0u;
#pragma unroll
        for (unsigned j = 0; j < 16; ++j) { const unsigned c = xb_ld(&bar[XB_XCNT(j)]); sum += c; cnt += (c > 0u) ? 1u : 0u; mine = (j == x) ? c : mine; }
        if (sum == G) break;
        __builtin_amdgcn_s_sleep(1);
        if ((++sp & 255u) == 0u) { if (xb_ld(&bar[XB_TMO])) break; if (sp > XB_SPIN_CAP) { atomicAdd(&bar[XB_TMO], 1u); break; } }
    }
    nloc = mine > 0u ? mine : 1u; nx = cnt > 0u ? cnt : 1u;
}
__device__ __forceinline__ void xcd_barrier(const XcdBarrier& b) {
    asm volatile("s_waitcnt vmcnt(0)" ::: "memory");
    __syncthreads();
    if (threadIdx.x == 0) {
        unsigned* bar = b.bar;
        __builtin_amdgcn_s_waitcnt(0);
        unsigned nloc = b.st[0], nx = b.st[1];
        if (nloc == 0u) { xcd_barrier_complete(bar, b.x, nloc, nx); b.st[0] = nloc; b.st[1] = nx; }
        const unsigned old = xb_add(&bar[XB_XSUB(b.x)], 1u);
        const unsigned gen = old / nloc;
        if (old + 1u == (gen + 1u) * nloc) {
            __builtin_amdgcn_fence(__ATOMIC_RELEASE, "agent");
            asm volatile("s_waitcnt vmcnt(0)" ::: "memory");
            const unsigned og = xb_add(&bar[XB_TOP], 1u);
            const unsigned tg = og / nx;
            if (og + 1u == (tg + 1u) * nx) xb_add(&bar[XB_TOPGEN], 1u);
            else XB_SPIN(xb_ld(&bar[XB_TOPGEN]) == tg, bar);
            __builtin_amdgcn_fence(__ATOMIC_ACQUIRE, "agent");
            xb_add(&bar[XB_XGEN(b.x)], 1u);
            asm volatile("s_waitcnt vmcnt(0)" ::: "memory");
        } else {
            XB_SPIN(xb_ld(&bar[XB_XGEN(b.x)]) == gen, bar);
            __builtin_amdgcn_fence(__ATOMIC_ACQUIRE, "agent");
            asm volatile("s_waitcnt vmcnt(0)" ::: "memory");
        }
    }
    __syncthreads();
}

constexpr int NWAVES = 8;
struct Args { const float* in[26]; float* out; unsigned char* ws; int ph_lo, ph_hi; };
static_assert(sizeof(Args) == 26 * 8 + 8 + 8 + 8, "Args has no padding");

struct Frame {
    LAS unsigned char* lds;
    int tid, lane, wave, vcu, G;
};
typedef const __attribute__((address_space(4))) Args* KArgs;
__device__ __forceinline__ KArgs get_args() { KArgs p = (KArgs)__builtin_amdgcn_kernarg_segment_ptr(); asm volatile("" : "+s"(p)); return p; }
enum In { I_X = 0, I_C, I_CTX, I_CCTX, I_WMOD, I_BMOD, I_NMPRE, I_NMPOST, I_NFPRE, I_NFPOST, I_NAQKV, I_NAWO, I_NARPB, I_DQKV, I_DWO, I_LQ1, I_LK1, I_LQ2, I_LK2, I_SUBLN,
          I_WR, I_BR, I_WGU, I_BGU, I_WDN, I_BDN };

__device__ __forceinline__ void p0_transpose_item(const float* W, int K, int N, bf16_t* WT, int drow0, int k0, int n0, LAS float* scr, int lane) {
#pragma unroll 8
    for (int i = 0; i < 32; ++i) { const int kk = 2 * i + (lane >> 5); scr[kk * 33 + (lane & 31)] = W[(size_t)(k0 + kk) * N + n0 + (lane & 31)]; }
    LDS_WAIT(); asm volatile("" ::: "memory");
    const int c = lane & 7;
#pragma unroll
    for (int j = 0; j < 4; ++j) { const int n = (lane >> 3) + 8 * j; const LAS float* s = scr + (8 * c) * 33 + n;
        u32x4 o; o.x = cvt_pk_bf16(s[0 * 33], s[1 * 33]); o.y = cvt_pk_bf16(s[2 * 33], s[3 * 33]); o.z = cvt_pk_bf16(s[4 * 33], s[5 * 33]); o.w = cvt_pk_bf16(s[6 * 33], s[7 * 33]);
        *(GAS u32x4*)(WT + (size_t)(drow0 + n) * K + k0 + 8 * c) = o; }
    LDS_WAIT(); asm volatile("" ::: "memory");
}

__device__ __forceinline__ void p0_transpose_item_f8(const float* W, int K, int N, unsigned char* WT, int drow0, int k0, int n0, LAS float* scr, int lane) {
#pragma unroll 8
    for (int i = 0; i < 32; ++i) { const int kk = 2 * i + (lane >> 5); scr[kk * 33 + (lane & 31)] = W[(size_t)(k0 + kk) * N + n0 + (lane & 31)] * 32.f; }
    LDS_WAIT(); asm volatile("" ::: "memory");
    const int c = lane & 7;
#pragma unroll
    for (int j = 0; j < 4; ++j) { const int n = (lane >> 3) + 8 * j; const LAS float* s = scr + (8 * c) * 33 + n;
        int w0 = __builtin_amdgcn_cvt_pk_fp8_f32(s[0 * 33], s[1 * 33], 0, false); w0 = __builtin_amdgcn_cvt_pk_fp8_f32(s[2 * 33], s[3 * 33], w0, true);
        int w1 = __builtin_amdgcn_cvt_pk_fp8_f32(s[4 * 33], s[5 * 33], 0, false); w1 = __builtin_amdgcn_cvt_pk_fp8_f32(s[6 * 33], s[7 * 33], w1, true);
        *(GAS u32x2*)(WT + (size_t)(drow0 + n) * K + k0 + 8 * c) = (u32x2){(unsigned)w0, (unsigned)w1}; }
    LDS_WAIT(); asm volatile("" ::: "memory");
}
__device__ __forceinline__ void p0_item64_f8(const float* W, int K, int N, unsigned char* WT, int drow0, int k0, int n0, LAS float* scr, int lane) {
#pragma unroll 8
    for (int i = 0; i < 64; ++i) scr[i * 65 + lane] = W[(size_t)(k0 + i) * N + n0 + lane] * 32.f;
    LDS_WAIT(); asm volatile("" ::: "memory");
    const int c = lane & 7;
#pragma unroll
    for (int j = 0; j < 8; ++j) { const int n = (lane >> 3) + 8 * j; const LAS float* s = scr + (8 * c) * 65 + n;
        int w0 = __builtin_amdgcn_cvt_pk_fp8_f32(s[0 * 65], s[1 * 65], 0, false); w0 = __builtin_amdgcn_cvt_pk_fp8_f32(s[2 * 65], s[3 * 65], w0, true);
        int w1 = __builtin_amdgcn_cvt_pk_fp8_f32(s[4 * 65], s[5 * 65], 0, false); w1 = __builtin_amdgcn_cvt_pk_fp8_f32(s[6 * 65], s[7 * 65], w1, true);
        *(GAS u32x2*)(WT + (size_t)(drow0 + n) * K + k0 + 8 * c) = (u32x2){(unsigned)w0, (unsigned)w1}; }
    LDS_WAIT(); asm volatile("" ::: "memory");
}
__device__ __forceinline__ void ld_row_f32(f32x4 (&v)[4], const float* p, int lane) {
#pragma unroll
    for (int j = 0; j < 4; ++j) v[j] = *(const f32x4*)(p + 4 * lane + 256 * j);
}
__device__ __forceinline__ void st_row_f32(float* p, const f32x4 (&v)[4], int lane) {
#pragma unroll
    for (int j = 0; j < 4; ++j) *(f32x4*)(p + 4 * lane + 256 * j) = v[j];
}
__device__ __forceinline__ void ld_row_bf16(f32x4 (&v)[4], const bf16_t* p, int lane) {
#pragma unroll
    for (int j = 0; j < 4; ++j) { const u32x2 w = *(const u32x2*)(p + 4 * lane + 256 * j); v[j] = (f32x4){bflo(w.x), bfhi(w.x), bflo(w.y), bfhi(w.y)}; }
}
__device__ __forceinline__ void st_row_bf16(bf16_t* p, const f32x4 (&v)[4], int lane) {
#pragma unroll
    for (int j = 0; j < 4; ++j) { u32x2 w; w.x = cvt_pk_bf16(v[j][0], v[j][1]); w.y = cvt_pk_bf16(v[j][2], v[j][3]); *(u32x2*)(p + 4 * lane + 256 * j) = w; }
}
__device__ __forceinline__ void st_row_fp8(unsigned char* p, const f32x4 (&v)[4], int lane) {
#pragma unroll
    for (int j = 0; j < 4; ++j) { int w = __builtin_amdgcn_cvt_pk_fp8_f32(v[j][0], v[j][1], 0, false); w = __builtin_amdgcn_cvt_pk_fp8_f32(v[j][2], v[j][3], w, true); *(int*)(p + 4 * lane + 256 * j) = w; }
}
__device__ __forceinline__ float row_sumsq(const f32x4 (&v)[4]) {
    float s = 0.f;
#pragma unroll
    for (int j = 0; j < 4; ++j) s += (v[j][0] * v[j][0] + v[j][1] * v[j][1]) + (v[j][2] * v[j][2] + v[j][3] * v[j][3]);
    return wave_sum(s);
}
__device__ __forceinline__ void norm_mod(f32x4 (&h)[4], const f32x4 (&x)[4], const float* w, const float* sc, const float* sh, int lane) {
    const float rs = 1.0f / sqrtf(row_sumsq(x) * (1.f / DM) + NORM_EPS);
#pragma unroll
    for (int j = 0; j < 4; ++j) { const int c = 4 * lane + 256 * j; const f32x4 wv = *(const f32x4*)(w + c), sv = *(const f32x4*)(sc + c), hv = *(const f32x4*)(sh + c);
        h[j] = (x[j] * rs) * wv * (sv + 1.f) + hv; }
}
__device__ __forceinline__ const float* src_row(KArgs a, int row) {
    return row < NLAT ? a->in[I_X] + (size_t)row * DM : a->in[I_CTX] + (size_t)(row - NLAT) * DM;
}

#define MOD ((float*)(ws + WS_MOD))
#define WRT ((float*)(ws + WS_WRT))
#define ROPE ((float*)(ws + WS_ROPE))
#define WQKV ((bf16_t*)(ws + WS_WQKV))
#define WO ((bf16_t*)(ws + WS_WO))
#define WGU8 ((unsigned char*)(ws + WS_WGU))
#define WDN8 ((unsigned char*)(ws + WS_WDN))
#define XS ((bf16_t*)(ws + WS_XS))
#define XN ((bf16_t*)(ws + WS_XN))
#define XNQ8 ((unsigned char*)(ws + WS_XN))
#define OB8 ((unsigned char*)(ws + WS_O))
#define WQKV8 ((unsigned char*)(ws + WS_WQKV))
#define WO8 ((unsigned char*)(ws + WS_WO))
#define QB ((bf16_t*)(ws + WS_Q))
#define KB ((bf16_t*)(ws + WS_K))
#define VB ((bf16_t*)(ws + WS_V))
#define OB ((bf16_t*)(ws + WS_O))
#define TB ((bf16_t*)(ws + WS_T))
#define ACT ((bf16_t*)(ws + WS_ACT))
#define ACT8 ((unsigned char*)(ws + WS_ACT))
#define XN8 ((unsigned char*)(ws + WS_XN8))
#define YB ((bf16_t*)(ws + WS_Y))
#define TOKOF ((int*)(ws + WS_TOKOF))
#define SLOT ((int*)(ws + WS_SLOT))
#define GATE ((float*)(ws + WS_GATE))
#define CTLW ((unsigned*)(ws + WS_CTL))
#if MK_SPLIT
#define GRID_BAR() do { } while (0)
#else
#define GRID_BAR() xcd_barrier(bar)
#endif
#define IN_PH() (lo <= ph && ph < hi)
#define END_PH() do { if (IN_PH() && ph + 1 < hi) GRID_BAR(); ++ph; } while (0)
__device__ __forceinline__ int opaque(int v) { asm volatile("" : "+v"(v)); return v; }
#define PH_BEGIN() KArgs A = get_args(); unsigned char* const ws = A->ws; (void)ws; const int lane = opaque((int)__builtin_amdgcn_mbcnt_hi(~0u, __builtin_amdgcn_mbcnt_lo(~0u, 0u))); (void)lane
constexpr int NQL = 32 * 512 + 32 * 256;
struct ConvBG {
    static constexpr int NH = 2 * 2 * NQL;
    KArgs A; unsigned char* ws; LAS float* scr; int lane, hq, hstride; bool pending; f32x4 v[8]; unsigned char* dst; int dK;
    __device__ __forceinline__ void step() {
        if (pending) {
            const int li = lane >> 4, lq = lane & 15;
#pragma unroll
            for (int r = 0; r < 8; ++r) { LAS float* d = scr + (4 * r + li) * 65 + 4 * lq; d[0] = v[r][0] * 32.f; d[1] = v[r][1] * 32.f; d[2] = v[r][2] * 32.f; d[3] = v[r][3] * 32.f; }
            LDS_WAIT(); asm volatile("" ::: "memory");
            const int c = lane & 3;
#pragma unroll
            for (int j = 0; j < 4; ++j) { const int n = (lane >> 2) + 16 * j; const LAS float* sp = scr + (8 * c) * 65 + n;
                int w0 = __builtin_amdgcn_cvt_pk_fp8_f32(sp[0 * 65], sp[1 * 65], 0, false); w0 = __builtin_amdgcn_cvt_pk_fp8_f32(sp[2 * 65], sp[3 * 65], w0, true);
                int w1 = __builtin_amdgcn_cvt_pk_fp8_f32(sp[4 * 65], sp[5 * 65], 0, false); w1 = __builtin_amdgcn_cvt_pk_fp8_f32(sp[6 * 65], sp[7 * 65], w1, true);
                *(GAS u32x2*)(dst + (size_t)n * dK + 8 * c) = (u32x2){(unsigned)w0, (unsigned)w1}; }
            LDS_WAIT(); asm volatile("" ::: "memory");
        }
        if (hq < NH) {
            const int q = hq >> 1, half = hq & 1, layer = q / NQL; int r = q - layer * NQL; const float* src; int N;
            if (r < 16384) { const int le = layer * 32 + (r >> 9); r &= 511; const int kb = r >> 5, nb = r & 31, n0 = 64 * nb, k0 = 64 * kb + 32 * half;
                const int drow = (n0 < FF) ? (n0 >> 7) * 256 + (n0 & 127) : ((n0 - FF) >> 7) * 256 + 128 + ((n0 - FF) & 127);
                N = 2 * FF; src = A->in[I_WGU] + (size_t)le * DM * 2 * FF + (size_t)k0 * N + n0; dst = WGU8 + (size_t)le * 2 * FF * DM + (size_t)drow * DM + k0; dK = DM; }
            else { r -= 16384; const int le = layer * 32 + (r >> 8); r &= 255; const int kb = r >> 4, nb = r & 15, k0 = 64 * kb + 32 * half;
                N = DM; src = A->in[I_WDN] + (size_t)le * FF * DM + (size_t)k0 * N + 64 * nb; dst = WDN8 + (size_t)le * DM * FF + (size_t)(64 * nb) * FF + k0; dK = FF; }
            const float* p = src + (size_t)(lane >> 4) * N + 4 * (lane & 15);
#pragma unroll
            for (int r8 = 0; r8 < 8; ++r8) v[r8] = __builtin_nontemporal_load((const f32x4*)(p + (size_t)(4 * r8) * N));
            pending = true; hq += hstride;
        } else pending = false;
    }
};
template <int l>
__device__ __forceinline__ void run_layer(const Frame& F, unsigned char* lds, const int lo, const int hi, int& ph
#if !MK_SPLIT
    , const XcdBarrier& bar
#endif
    ) {
    const int lane = opaque(F.lane);
    const int gw = F.vcu * NWAVES + F.wave, NGW = F.G * NWAVES;
    LAS int* T_cnt = (LAS int*)(F.lds + TAB_OFF);
    LAS int* T_ts = (LAS int*)(F.lds + TAB_OFF + 128);
    LAS int* T_te = (LAS int*)(F.lds + TAB_OFF + 512);
    LAS int* T_hist = (LAS int*)(F.lds + TAB_OFF + 4096);
    LAS int* T_base = (LAS int*)(F.lds + TAB_OFF + 4096 + 128);
    LAS int* T_info = (LAS int*)(F.lds + TAB_OFF + 4608);
        if (IN_PH()) { PH_BEGIN();
            pg8::DenseOrder S; S.init(NTOK / 256, 12, F.G, (int)blockIdx.x);
            pg8::EpiQKV E{QB, (size_t)(WS_K - WS_Q) / 2, QSCALE, l == 1 ? ROPE : nullptr, ((DENSE_FP8 >> l) & 1) ? 0.03125f : 1.f};
            for (int rep = 0; rep < REP_DENSE; ++rep)
            if constexpr (((DENSE_FP8 >> l) & 1) != 0) pg8::gemm_phase<1>(F.lds, XNQ8, WQKV8 + (size_t)l * 6 * DM * DM, DM, 0, S, E, pg8::RowDense{});
            else pg8::gemm_phase<2>(F.lds, XN, WQKV + (size_t)l * 3 * DM * DM, DM, 0, S, E, pg8::RowDense{});
        }
        END_PH();
        if constexpr (l == 1) {
            if (IN_PH()) { PH_BEGIN();
                LAS unsigned short* vt_l = (LAS unsigned short*)F.lds;
                unsigned char* VT8 = (unsigned char*)ACT;
                u32x4 a0 = (u32x4){0u, 0u, 0u, 0u}, a1 = a0;
#define VT_LOAD(TT) do { const int t_ = (TT) % 260, bh_ = (TT) / 260, h_ = bh_ & 7, b_ = bh_ >> 3; \
                    const int trow_ = t_ < 256 ? b_ * SEQ + t_ * 64 : NLAT + b_ * CTXL + (t_ - 256) * 64; \
                    const bf16_t* srcp = VB + (size_t)(trow_ + (F.tid >> 3)) * DM + h_ * 128 + (F.tid & 7) * 16; a0 = *(const u32x4*)srcp; a1 = *(const u32x4*)(srcp + 8); } while (0)
                if (F.vcu < BATCH * 8 * 260) VT_LOAD(F.vcu);
                for (int T = F.vcu; T < BATCH * 8 * 260; T += F.G) {
                    { const int k = F.tid >> 3, c16 = (F.tid & 7) * 16;
                      *(LAS u32x4*)(vt_l + k * 136 + c16) = a0; *(LAS u32x4*)(vt_l + k * 136 + c16 + 8) = a1; }
                    __syncthreads();
                    if (T + F.G < BATCH * 8 * 260) VT_LOAD(T + F.G);
                    { const int c = F.tid & 127, ch = F.tid >> 7, hh = ch >> 1, half = ch & 1; float f[16];
#pragma unroll
                      for (int e = 0; e < 16; ++e) { const int key = half * 32 + att::crow(e, hh); f[e] = __uint_as_float((unsigned)vt_l[key * 136 + c] << 16); }
                      u32x4 w;
#pragma unroll
                      for (int q = 0; q < 4; ++q) { int t_ = __builtin_amdgcn_cvt_pk_fp8_f32(f[4 * q], f[4 * q + 1], 0, false); t_ = __builtin_amdgcn_cvt_pk_fp8_f32(f[4 * q + 2], f[4 * q + 3], t_, true); w[q] = (unsigned)t_; }
                      *(u32x4*)(VT8 + (size_t)T * 8192 + c * 64 + ((ch ^ ((c >> 2) & 3)) * 16)) = w; }
                    __syncthreads();
                }
#undef VT_LOAD
            }
            END_PH();
        }
        if (IN_PH()) { PH_BEGIN();
            if constexpr (l == 0) {
                using L = att::Lay<64>;
                LAS float* bias_l = (LAS float*)(F.lds + L::OFF_BIAS);
                ConvBG bg; bg.A = A; bg.ws = ws; bg.scr = (LAS float*)(F.lds + L::END + F.wave * 8320); bg.lane = lane; bg.hq = gw; bg.hstride = NGW; bg.pending = false; bg.dst = nullptr; bg.dK = 0;
                static_assert(L::END + NWAVES * 8320 <= TAB_OFF, "background scratch");
                for (int rep = 0; rep < REP_NA; ++rep)
                for (int u = F.vcu; u < 2048 + 32; u += F.G) {
                    f32x16 o[2]; int qrow0, hh;
                    if (u < 2048) {
                        const int rg = u & 63, h = (u >> 6) & 15, b = u >> 10; hh = h;
                        for (int i = opaque(F.tid); i < 15 * 32; i += NWAVES * 64) { const int dr_ = i >> 5, dc_ = i & 31; bias_l[i] = dc_ < 31 ? A->in[I_NARPB][h * 465 + dr_ * 31 + dc_] * LOG2E : -INFINITY; }
                        const int R = 4 * rg + (F.wave >> 1), r0R = min(max(R - 4, 0), 248), rmin = min(max(4 * rg - 4, 0), 248), rmax = min(max(4 * rg + 3 - 4, 0), 248) + 7;
                        qrow0 = b * SEQ + 256 * rg + 32 * F.wave;
                        att::attn_run<64, true>(o, QB + (size_t)qrow0 * DM + h * 64, KB + h * 64, VB + h * 64, b * SEQ + rmin * 64, rmax - rmin + 1, NLAT + b * CTXL, 4,
                                                (char*)lds, r0R - rmin, rmin - R + 7, 32 * (F.wave & 1) + (lane & 31), bg);
                    } else {
                        const int v = u - 2048, h = v & 15, b = v >> 4; hh = h;
                        qrow0 = NLAT + b * CTXL + 32 * F.wave;
                        att::attn_run<64, false>(o, QB + (size_t)qrow0 * DM + h * 64, KB + h * 64, VB + h * 64, 0, 0, NLAT + b * CTXL, 4, (char*)lds, 0, 0, 0, bg);
                    }
                    const int r32 = lane & 31, hi2 = lane >> 5;
#pragma unroll
                    for (int r = 0; r < 16; ++r) {
#if (DENSE_FP8 & 4)
                        unsigned char* op = OB8 + (size_t)(qrow0 + att::crow(r, hi2)) * DM + hh * 64 + r32;
#pragma unroll
                        for (int d = 0; d < 2; ++d) op[32 * d] = (unsigned char)(__builtin_amdgcn_cvt_pk_fp8_f32(o[d][r] * 8.f, 0.f, 0, false) & 0xff);
#else
                        bf16_t* op = OB + (size_t)(qrow0 + att::crow(r, hi2)) * DM + hh * 64 + r32;
#pragma unroll
                        for (int d = 0; d < 2; ++d) op[32 * d] = (bf16_t)(cvt_pk_bf16(o[d][r], 0.f) & 0xffffu);
#endif
                    }
                }
                while (bg.pending || bg.hq < ConvBG::NH) bg.step();
            } else {
                LAS unsigned* stash = (LAS unsigned*)(F.lds + att::DA_END);
                float lam;
                { const float a = A->in[I_LQ1][lane] * A->in[I_LK1][lane], b2 = A->in[I_LQ2][lane] * A->in[I_LK2][lane];
                  lam = __expf(wave_sum(a)) - __expf(wave_sum(b2)) + LAMBDA_INIT; }
                const bool xmap = (F.G % 8 == 0) && (F.G >= 8);
                const int nper = xmap ? F.G / 8 : F.G, ustart = xmap ? F.vcu % nper : F.vcu, uend = xmap ? 128 : 1024;
                for (int rep = 0; rep < REP_DIFF; ++rep)
                for (int u = ustart; u < uend; u += nper) {
                    const int h = xmap ? F.vcu / nper : (u & 7), qb = xmap ? (u & 63) : ((u >> 3) & 63), b = xmap ? (u >> 6) : (u >> 9);
                    const int qrow0 = b * SEQ + 256 * qb + 32 * F.wave;
                    f32x16 o[4];
                    att::dattn_run<0>(o, (const unsigned char*)QB + (size_t)qrow0 * DM + (2 * h) * 64, (const unsigned char*)KB + (2 * h) * 64, (const unsigned char*)ACT + (size_t)((b * 8 + h) * 260) * 8192, b * SEQ, NLAT + b * CTXL, (char*)lds);
{ LAS unsigned* st1 = (LAS unsigned*)(uintptr_t)(unsigned)opaque((int)(uintptr_t)(stash + F.tid));
#pragma unroll
                    for (int d = 0; d < 4; ++d)
#pragma unroll
                        for (int r = 0; r < 16; r += 2) st1[(d * 8 + (r >> 1)) * 512] = cvt_pk_bf16(o[d][r], o[d][r + 1]); }
                    f32x16 o2[4];
                    att::dattn_run<0>(o2, (const unsigned char*)QB + (size_t)qrow0 * DM + (2 * h + 1) * 64, (const unsigned char*)KB + (2 * h + 1) * 64, (const unsigned char*)ACT + (size_t)((b * 8 + h) * 260) * 8192, b * SEQ, NLAT + b * CTXL, (char*)lds);
                    float ss[16];
#pragma unroll
                    for (int r = 0; r < 16; ++r) ss[r] = 0.f;
LAS unsigned* st2 = (LAS unsigned*)(uintptr_t)(unsigned)opaque((int)(uintptr_t)(stash + F.tid));
#pragma unroll
                    for (int d = 0; d < 4; ++d)
#pragma unroll
                        for (int r = 0; r < 16; r += 2) { const unsigned w = st2[(d * 8 + (r >> 1)) * 512];
                            o2[d][r] = bflo(w) - lam * o2[d][r]; o2[d][r + 1] = bfhi(w) - lam * o2[d][r + 1];
                            ss[r] += o2[d][r] * o2[d][r]; ss[r + 1] += o2[d][r + 1] * o2[d][r + 1]; }
#pragma unroll
                    for (int r = 0; r < 16; ++r) { float s_ = ss[r];
                        s_ += DPPF(s_, 0xB1, 0xF, 0.f); s_ += DPPF(s_, 0x4E, 0xF, 0.f); s_ += DPPF(s_, 0x141, 0xF, 0.f); s_ += DPPF(s_, 0x140, 0xF, 0.f);
                        { auto rr = __builtin_amdgcn_permlane16_swap(__float_as_uint(s_), __float_as_uint(s_), false, false); s_ = __uint_as_float(rr[0]) + __uint_as_float(rr[1]); }
                        ss[r] = s_; }
                    const int ln = opaque(lane);
                    const int r32 = ln & 31, hi2 = ln >> 5;
                    float sub[4];
#pragma unroll
                    for (int d = 0; d < 4; ++d) sub[d] = A->in[I_SUBLN][32 * d + r32] * (1.f - LAMBDA_INIT);
#pragma unroll
                    for (int r = 0; r < 16; ++r) { const float rs = 1.0f / sqrtf(ss[r] * (1.f / 128.f) + DIFF_EPS);
#if (DENSE_FP8 & 8)
                        unsigned char* op = OB8 + (size_t)(qrow0 + att::crow(r, hi2)) * DM + h * 128 + r32;
#pragma unroll
                        for (int d = 0; d < 4; ++d) op[32 * d] = (unsigned char)(__builtin_amdgcn_cvt_pk_fp8_f32(o2[d][r] * rs * sub[d], 0.f, 0, false) & 0xff); }
#else
                        bf16_t* op = OB + (size_t)(qrow0 + att::crow(r, hi2)) * DM + h * 128 + r32;
#pragma unroll
                        for (int d = 0; d < 4; ++d) op[32 * d] = (bf16_t)(cvt_pk_bf16(o2[d][r] * rs * sub[d], 0.f) & 0xffffu); }
#endif
                }
#if REP_ABL
                for (int rep = 0; rep < REP_ABL; ++rep)
                for (int u = ustart; u < uend; u += nper) {
                    const int h = xmap ? F.vcu / nper : (u & 7), qb = xmap ? (u & 63) : ((u >> 3) & 63), b = xmap ? (u >> 6) : (u >> 9);
                    const int qrow0 = b * SEQ + 256 * qb + 32 * F.wave;
                    f32x16 o[4];
                    att::dattn_run<ABLV>(o, (const unsigned char*)QB + (size_t)qrow0 * DM + (2 * h) * 64, (const unsigned char*)KB + (2 * h) * 64, (const unsigned char*)ACT + (size_t)((b * 8 + h) * 260) * 8192, b * SEQ, NLAT + b * CTXL, (char*)lds);
                    const int r32 = lane & 31, hi2 = lane >> 5;
#pragma unroll
                    for (int r = 0; r < 16; ++r) { bf16_t* op = YB + (size_t)(qrow0 + att::crow(r, hi2)) * DM + h * 128 + r32;
#pragma unroll
                        for (int d = 0; d < 4; ++d) op[32 * d] = (bf16_t)(cvt_pk_bf16(o[d][r], 0.f) & 0xffffu); }
                }
#endif
            }
        }
        END_PH();
        if (IN_PH()) { PH_BEGIN();
            pg8::DenseOrder S; S.init((l == 0 ? NTOK : NLAT) / 256, 4, F.G, (int)blockIdx.x);
            if constexpr (((DENSE_FP8 >> (2 + l)) & 1) != 0) { pg8::EpiPlain E{TB, nullptr, l == 0 ? 0.03125f * 0.125f : 0.03125f};
                pg8::gemm_phase<1>(F.lds, OB8, WO8 + (size_t)l * 2 * DM * DM, DM, 0, S, E, pg8::RowDense{}); }
            else { pg8::EpiPlain E{TB, nullptr, 1.f};
                pg8::gemm_phase<2>(F.lds, OB, WO + (size_t)l * DM * DM, DM, 0, S, E, pg8::RowDense{}); }
        }
        END_PH();
        if (IN_PH()) { PH_BEGIN();
            const int nrows = (l == 0) ? NTOK : NLAT, chunk = (nrows + F.G - 1) / F.G, row_lo = min((int)blockIdx.x * chunk, nrows), row_hi = min(row_lo + chunk, nrows);
            LAS float* wr_l = (LAS float*)F.lds;
            for (int i = opaque(F.tid); i < NE * DM / 4; i += NWAVES * 64) ((LAS f32x4*)wr_l)[i] = ((const f32x4*)(WRT + (size_t)l * NE * DM))[i];
            if (F.tid < NE) T_hist[F.tid] = 0;
            __syncthreads();
            const float brl = A->in[I_BR][l * NE + (lane >> 1)];
            for (int row0 = row_lo + 2 * F.wave; row0 < row_hi; row0 += 2 * NWAVES) {
                const bool two = row0 + 1 < row_hi;
                f32x2 hp[4][4];
                u32x2 traw[2][4], xraw[2][4]; f32x4 xf[2][4];
#pragma unroll
                for (int rr = 0; rr < 2; ++rr) { const int row = (rr == 1 && !two) ? row0 : row0 + rr;
#pragma unroll
                    for (int j = 0; j < 4; ++j) { traw[rr][j] = *(const u32x2*)(TB + (size_t)row * DM + 4 * lane + 256 * j);
                        if (l == 0) xf[rr][j] = *(const f32x4*)(src_row(A, row) + 4 * lane + 256 * j); else xraw[rr][j] = *(const u32x2*)(XS + (size_t)row * DM + 4 * lane + 256 * j); } }
#pragma unroll
                for (int rr = 0; rr < 2; ++rr) {
                    const int row = (rr == 1 && !two) ? row0 : row0 + rr;
                    const int mb = row < NLAT ? (row >> 14) : 2; const float* md = MOD + ((size_t)l * 3 + mb) * 6144;
                    f32x4 t[4], x[4], h[4];
#pragma unroll
                    for (int j = 0; j < 4; ++j) { const u32x2 w = traw[rr][j]; t[j] = (f32x4){bflo(w.x), bfhi(w.x), bflo(w.y), bfhi(w.y)};
                        if (l == 0) x[j] = xf[rr][j]; else { const u32x2 q = xraw[rr][j]; x[j] = (f32x4){bflo(q.x), bfhi(q.x), bflo(q.y), bfhi(q.y)}; } }
                    const float rs = 1.0f / sqrtf(row_sumsq(t) * (1.f / DM) + NORM_EPS);
#pragma unroll
                    for (int j = 0; j < 4; ++j) { const int c = 4 * lane + 256 * j; const f32x4 wv = *(const f32x4*)(A->in[I_NMPOST] + l * DM + c), gv = *(const f32x4*)(md + 2 * DM + c);
                        x[j] = x[j] + gv * ((t[j] * rs) * wv); }
                    const bool live = (rr == 0) || two;
                    if (live) st_row_bf16(XS + (size_t)row * DM, x, lane);
                    norm_mod(h, x, A->in[I_NFPRE] + l * DM, md + 4 * DM, md + 3 * DM, lane);
                    if (live) st_row_fp8(XN8 + (size_t)row * DM, h, lane);
#pragma unroll
                    for (int j = 0; j < 4; ++j)
#pragma unroll
                        for (int k = 0; k < 4; ++k) hp[j][k][rr] = h[j][k];
                }
                f32x2 acc[32];
#pragma unroll
                for (int e = 0; e < 32; ++e) { f32x2 s2 = (f32x2){0.f, 0.f};
#pragma unroll
                    for (int j = 0; j < 4; ++j) { const f32x4 w = *(const LAS f32x4*)(wr_l + e * DM + 256 * j + 4 * lane);
#pragma unroll
                        for (int k = 0; k < 4; ++k) s2 = hp[j][k] * (f32x2){w[k], w[k]} + s2; }
                    acc[e] = s2; }
#pragma unroll
                for (int rr = 0; rr < 2; ++rr) {
                if (rr == 1 && !two) break;
                const int row = row0 + rr;
                float v[32];
#pragma unroll
                for (int e = 0; e < 32; ++e) v[e] = acc[e][rr];
#pragma unroll
                for (int i = 0; i < 16; ++i) { auto rr = __builtin_amdgcn_permlane32_swap(__float_as_uint(v[i]), __float_as_uint(v[16 + i]), false, false); v[i] = __uint_as_float(rr[0]) + __uint_as_float(rr[1]); }
#pragma unroll
                for (int i = 0; i < 8; ++i) { auto rr = __builtin_amdgcn_permlane16_swap(__float_as_uint(v[i]), __float_as_uint(v[8 + i]), false, false); v[i] = __uint_as_float(rr[0]) + __uint_as_float(rr[1]); }
#pragma unroll
                for (int i = 0; i < 4; ++i) { const bool up = (lane & 8) != 0; const float send = up ? v[i] : v[4 + i], keep = up ? v[4 + i] : v[i]; v[i] = keep + DPPF(send, 0x128, 0xF, 0.f); }
#pragma unroll
                for (int i = 0; i < 2; ++i) { const bool up = (lane & 4) != 0; const float send = up ? v[i] : v[2 + i], keep = up ? v[2 + i] : v[i];
                    const float r4 = DPPF(send, 0x124, 0xF, 0.f), r12 = DPPF(send, 0x12C, 0xF, 0.f); v[i] = keep + (up ? r4 : r12); }
                { const bool up = (lane & 2) != 0; const float send = up ? v[0] : v[1], keep = up ? v[1] : v[0]; v[0] = keep + DPPF(send, 0x4E, 0xF, 0.f); }
                float val = v[0] + DPPF(v[0], 0xB1, 0xF, 0.f) + brl;
                int te[4]; float tv[4];
#pragma unroll
                for (int k = 0; k < 4; ++k) {
                    const float m = wave_max(val);
                    const unsigned long long bal = __ballot(val == m);
                    const int first = __builtin_ctzll(bal); te[k] = first >> 1; tv[k] = m;
                    if ((lane >> 1) == te[k]) val = -INFINITY;
                }
                const float e1 = __expf(tv[1] - tv[0]), e2 = __expf(tv[2] - tv[0]), e3 = __expf(tv[3] - tv[0]), inv = 1.f / (1.f + e1 + e2 + e3);
                if (lane < 4) {
                    const int e = lane == 0 ? te[0] : lane == 1 ? te[1] : lane == 2 ? te[2] : te[3];
                    const float g = (lane == 0 ? 1.f : lane == 1 ? e1 : lane == 2 ? e2 : e3) * inv;
                    const int rank = __hip_atomic_fetch_add(&T_hist[e], 1, __ATOMIC_RELAXED, __HIP_MEMORY_SCOPE_WORKGROUP);
                    T_info[(row - row_lo) * 4 + lane] = e | (rank << 8);
                    GATE[(size_t)row * 4 + lane] = g;
                }
            }
            }
            __syncthreads();
            { const int t_ = opaque(F.tid); if (t_ < NE) T_base[t_] = (int)__hip_atomic_fetch_add(CTLW + CW_CNT + l * NE + t_, (unsigned)T_hist[t_], RLX_AGENT); }
            __syncthreads();
            for (int i = opaque(F.tid); i < (row_hi - row_lo) * 4; i += NWAVES * 64) { const int inf = T_info[i], e = inf & 255, pos = T_base[e] + (inf >> 8); const int row = row_lo + (i >> 2);
                TOKOF[e * NTOK + pos] = row; SLOT[(size_t)row * 4 + (i & 3)] = e | (pos << 8); }
            __syncthreads();
        }
        END_PH();
        int n_tiles = 0;
        if (lo <= ph + 2 && ph < hi) { PH_BEGIN();
            __syncthreads();
            if (F.tid == 0) { int ts = 0; for (int e = 0; e < NE; ++e) { const int c = (int)__hip_atomic_load(CTLW + CW_CNT + l * NE + e, RLX_AGENT); T_cnt[e] = c; T_ts[e] = ts; ts += (c + 255) >> 8; } T_ts[NE] = ts; }
            __syncthreads();
            n_tiles = T_ts[NE]; if (n_tiles > MAXTILES) n_tiles = MAXTILES;
            for (int i = F.tid; i < n_tiles; i += NWAVES * 64) { int e = 0; while (e < NE - 1 && i >= T_ts[e + 1]) ++e; T_te[i] = e; }
            __syncthreads();
        }
        if (IN_PH()) { PH_BEGIN();
            pg8::MoeOrder S; S.init(n_tiles, 8, F.G, (int)blockIdx.x, T_te);
            pg8::EpiSwiGLU E{ACT8, A->in[I_BGU] + (size_t)l * NE * 2 * FF};
            pg8::RowMoe RM{TOKOF, T_cnt, T_ts};
            for (int rep = 0; rep < REP_MOE; ++rep)
            pg8::gemm_phase<1>(F.lds, XN8, WGU8 + (size_t)l * NE * 2 * FF * DM, DM, (size_t)2 * FF * DM, S, E, RM);
        }
        END_PH();
        if (IN_PH()) { PH_BEGIN();
            pg8::MoeOrder S; S.init(n_tiles, 4, F.G, (int)blockIdx.x, T_te);
            pg8::EpiPlain E{YB, A->in[I_BDN] + (size_t)l * NE * DM, 0.03125f};
            for (int rep = 0; rep < REP_MOE; ++rep)
            pg8::gemm_phase<1>(F.lds, ACT8, WDN8 + (size_t)l * NE * DM * FF, FF, (size_t)DM * FF, S, E, pg8::RowDense{});
        }
        END_PH();
        if (IN_PH()) { PH_BEGIN();
            const int nrows = (l == 0) ? NTOK : NLAT;
            for (int row = gw; row < nrows; row += NGW) {
                const int mb = row < NLAT ? (row >> 14) : 2; const float* md = MOD + ((size_t)l * 3 + mb) * 6144;
                f32x4 y[4];
#pragma unroll
                for (int j = 0; j < 4; ++j) y[j] = (f32x4){0.f, 0.f, 0.f, 0.f};
#pragma unroll
                for (int k = 0; k < 4; ++k) { const int inf = SLOT[(size_t)row * 4 + k], e = inf & 255, pos = inf >> 8; const float g = GATE[(size_t)row * 4 + k];
                    const size_t slot = (size_t)T_ts[e] * 256 + pos; f32x4 t[4]; ld_row_bf16(t, YB + slot * DM, lane);
#pragma unroll
                    for (int j = 0; j < 4; ++j) y[j] = y[j] + t[j] * g; }
                const float rs = 1.0f / sqrtf(row_sumsq(y) * (1.f / DM) + NORM_EPS);
                f32x4 x[4]; ld_row_bf16(x, XS + (size_t)row * DM, lane);
#pragma unroll
                for (int j = 0; j < 4; ++j) { const int c = 4 * lane + 256 * j; const f32x4 wv = *(const f32x4*)(A->in[I_NFPOST] + l * DM + c), gv = *(const f32x4*)(md + 5 * DM + c);
                    x[j] = x[j] + gv * ((y[j] * rs) * wv); }
                if (l == 0) {
                    st_row_bf16(XS + (size_t)row * DM, x, lane);
                    const float* md1 = MOD + (size_t)(3 + mb) * 6144; f32x4 h[4];
                    norm_mod(h, x, A->in[I_NMPRE] + DM, md1 + DM, md1, lane);
                    if (DENSE_FP8 & 2) st_row_fp8(XNQ8 + (size_t)row * DM, h, lane); else st_row_bf16(XN + (size_t)row * DM, h, lane);
                } else {
                    st_row_f32(A->out + (size_t)row * DM, x, lane);
                }
            }
        }
        END_PH();
}

__global__ void __launch_bounds__(NWAVES * 64, 2) mk_fwd(Args args) {
    extern __shared__ __attribute__((aligned(16))) unsigned char lds[];
    Frame F;
    F.lds = (LAS unsigned char*)lds;
    F.tid = threadIdx.x; F.lane = F.tid & 63; F.wave = __builtin_amdgcn_readfirstlane(F.tid >> 6);
    F.G = gridDim.x; { const int bx = blockIdx.x; F.vcu = (F.G % 8 == 0) ? (bx % 8) * (F.G / 8) + bx / 8 : bx; }
    volatile LAS unsigned* MISC = (volatile LAS unsigned*)(F.lds + MISC_OFF);
    for (int u = opaque(F.tid); u < (LDS_BYTES - MISC_OFF) / 4; u += NWAVES * 64) ((LAS unsigned*)(F.lds + MISC_OFF))[u] = 0u;
    __syncthreads();
#if !MK_SPLIT
    XcdBarrier bar = xcd_barrier_post((unsigned*)(get_args()->ws + WS_CTL) + CW_BAR, MISC + 8);
#endif
    int lo, hi; { KArgs A0 = get_args(); lo = A0->ph_lo; hi = A0->ph_hi; }
    int ph = 0;
    const int gw = F.vcu * NWAVES + F.wave, NGW = F.G * NWAVES;
    const int lane = F.lane;
    LAS int* T_cnt = (LAS int*)(F.lds + TAB_OFF);
    LAS int* T_ts = (LAS int*)(F.lds + TAB_OFF + 128);
    LAS int* T_te = (LAS int*)(F.lds + TAB_OFF + 512);
    LAS int* T_hist = (LAS int*)(F.lds + TAB_OFF + 4096);
    LAS int* T_base = (LAS int*)(F.lds + TAB_OFF + 4096 + 128);
    LAS int* T_info = (LAS int*)(F.lds + TAB_OFF + 4608);

    if (IN_PH()) for (int rep = 0; rep < REP_PRO; ++rep) { PH_BEGIN();
        if ((int)blockIdx.x < 192) {
            LAS float* sl = (LAS float*)F.lds;
            for (int i = F.tid; i < 3 * DM; i += NWAVES * 64) { const int m = i >> 10, k = i & 1023; const float c = (m < 2) ? A->in[I_C][m * DM + k] : A->in[I_CCTX][k]; sl[i] = c / (1.f + __expf(-c)); }
            __syncthreads();
            const int l = blockIdx.x / 96, cg = blockIdx.x % 96, col = cg * 64 + lane;
            const float* wm = A->in[I_WMOD] + (size_t)l * DM * 6144 + col;
            float a0 = 0.f, a1 = 0.f, a2 = 0.f;
            for (int k = F.wave * 128; k < F.wave * 128 + 128; ++k) { const float w = wm[(size_t)k * 6144]; a0 += sl[k] * w; a1 += sl[DM + k] * w; a2 += sl[2 * DM + k] * w; }
            LAS float* red = sl + 3 * DM;
            red[(F.wave * 3 + 0) * 64 + lane] = a0; red[(F.wave * 3 + 1) * 64 + lane] = a1; red[(F.wave * 3 + 2) * 64 + lane] = a2;
            __syncthreads();
            if (F.wave < 3) { float s = A->in[I_BMOD][l * 6144 + col];
#pragma unroll
                for (int w = 0; w < 8; ++w) s += red[(w * 3 + F.wave) * 64 + lane];
                MOD[((size_t)l * 3 + F.wave) * 6144 + col] = s; }
            __syncthreads();
        }
        for (int i = blockIdx.x * (NWAVES * 64) + F.tid; i < SEQ * 32; i += F.G * NWAVES * 64) {
            const int t = i >> 5, j = i & 31; const float pos = (float)(j < 16 ? (t >> 6) : (t & 63));
            const float inv = exp2f(-(float)(j & 15) * (13.287712379549449f / 16.f));
            const float ang = pos * inv; float sn, cs; sn = sinf(ang); cs = cosf(ang);
            *(f32x2*)(ROPE + (size_t)i * 2) = (f32x2){cs, sn};
        }
        for (int i = blockIdx.x * (NWAVES * 64) + F.tid; i < 2 * NE * DM; i += F.G * NWAVES * 64) { const int l = i >> 15, e = (i >> 10) & 31, k = i & 1023; WRT[i] = A->in[I_WR][((size_t)l * DM + k) * NE + e]; }
        {
            LAS float* scr = (LAS float*)(F.lds + F.wave * 16640);
            constexpr int I_QKV = 16 * 48, I_WOI = 16 * 16, I_GU = 16 * 32, I_DN = 16 * 16;
            constexpr int NITEMS = 2 * I_QKV + 2 * I_WOI;
            for (int it = gw; it < NITEMS; it += NGW) {
                int r = it;
                if (r < 2 * I_QKV) { const int l = r / I_QKV; r %= I_QKV; const int kb = r / 48, nb = r % 48; const float* wsrc = l == 0 ? A->in[I_NAQKV] : A->in[I_DQKV];
                    if ((DENSE_FP8 >> l) & 1) p0_item64_f8(wsrc, DM, 3 * DM, WQKV8 + (size_t)l * 6 * DM * DM, 64 * nb, 64 * kb, 64 * nb, scr, lane);
                    else { p0_transpose_item(wsrc, DM, 3 * DM, WQKV + (size_t)l * 3 * DM * DM, 64 * nb, 64 * kb, 64 * nb, scr, lane); p0_transpose_item(wsrc, DM, 3 * DM, WQKV + (size_t)l * 3 * DM * DM, 64 * nb + 32, 64 * kb, 64 * nb + 32, scr, lane); }
                    continue; }
                r -= 2 * I_QKV;
                if (r < 2 * I_WOI) { const int l = r / I_WOI; r %= I_WOI; const int kb = r / 16, nb = r % 16; const float* wsrc = l == 0 ? A->in[I_NAWO] : A->in[I_DWO];
                    if ((DENSE_FP8 >> (2 + l)) & 1) p0_item64_f8(wsrc, DM, DM, WO8 + (size_t)l * 2 * DM * DM, 64 * nb, 64 * kb, 64 * nb, scr, lane);
                    else { p0_transpose_item(wsrc, DM, DM, WO + (size_t)l * DM * DM, 64 * nb, 64 * kb, 64 * nb, scr, lane); p0_transpose_item(wsrc, DM, DM, WO + (size_t)l * DM * DM, 64 * nb + 32, 64 * kb, 64 * nb + 32, scr, lane); }
                    continue; }
            }
        }
    }
    END_PH();
    if (IN_PH()) { PH_BEGIN();
        for (int row = gw; row < NTOK; row += NGW) {
            const int mb = row < NLAT ? (row >> 14) : 2;
            f32x4 x[4], h[4]; ld_row_f32(x, src_row(A, row), lane);
            norm_mod(h, x, A->in[I_NMPRE], MOD + (size_t)mb * 6144 + DM, MOD + (size_t)mb * 6144, lane);
            if (DENSE_FP8 & 1) st_row_fp8(XNQ8 + (size_t)row * DM, h, lane); else st_row_bf16(XN + (size_t)row * DM, h, lane);
        }
    }
    END_PH();

#if MK_SPLIT
    run_layer<0>(F, lds, lo, hi, ph);
    run_layer<1>(F, lds, lo, hi, ph);
#else
    run_layer<0>(F, lds, lo, hi, ph, bar);
    run_layer<1>(F, lds, lo, hi, ph, bar);
#endif
}
constexpr int N_PHASES = 2 + 2 * 7 + 1;

extern "C" void kernel_launch(void* const* d_in, const int* in_sizes, int n_in, void* d_out, int out_size, void* d_ws, size_t ws_size, hipStream_t stream) {
    static int grid = 0;
    if (grid == 0) {
        if (n_in != 26 || in_sizes[0] != NLAT * DM || out_size != NLAT * DM || ws_size < WS_END) { fprintf(stderr, "kernel_launch: unexpected shapes: n_in %d in0 %d out %d ws %zu (need %zu)\n", n_in, n_in > 0 ? in_sizes[0] : -1, out_size, ws_size, (size_t)WS_END); grid = -1; return; }
        int dev = 0, cus = 0, per_cu = 0;
        if (hipGetDevice(&dev) != hipSuccess || hipDeviceGetAttribute(&cus, hipDeviceAttributeMultiprocessorCount, dev) != hipSuccess) { grid = -1; return; }
        if (hipFuncSetAttribute((const void*)mk_fwd, hipFuncAttributeMaxDynamicSharedMemorySize, LDS_BYTES) != hipSuccess) { fprintf(stderr, "kernel_launch: hipFuncSetAttribute failed\n"); grid = -1; return; }
        if (hipOccupancyMaxActiveBlocksPerMultiprocessor(&per_cu, (const void*)mk_fwd, NWAVES * 64, LDS_BYTES) != hipSuccess || per_cu < 1) fprintf(stderr, "kernel_launch: occupancy query reports %d\n", per_cu);
        (void)hipGetLastError();
        grid = cus;
    }
    if (grid < 0) return;
    if (hipMemsetAsync((char*)d_ws + WS_CTL, 0, CTL_ZERO_BYTES, stream) != hipSuccess) return;
    Args a{};
    for (int i = 0; i < 26; ++i) a.in[i] = (const float*)d_in[i];
    a.out = (float*)d_out; a.ws = (unsigned char*)d_ws;
#if MK_SPLIT
    for (int p = 0; p < N_PHASES; ++p) { a.ph_lo = p; a.ph_hi = p + 1; hipLaunchKernelGGL(mk_fwd, dim3(grid), dim3(NWAVES * 64), LDS_BYTES, stream, a); }
#else
    a.ph_lo = 0; a.ph_hi = N_PHASES;
    hipLaunchKernelGGL(mk_fwd, dim3(grid), dim3(NWAVES * 64), LDS_BYTES, stream, a);
#endif
    const hipError_t le = hipPeekAtLastError();
    if (le != hipSuccess) fprintf(stderr, "kernel_launch: launch failed: %s\n", hipGetErrorName(le));
}
```

```cpp
#include <hip/hip_runtime.h>
#include <cstdio>
#include <cstdint>

#ifndef MK_SPLIT
#define MK_SPLIT 0
#endif

#ifndef REP_DIFF
#define REP_DIFF 1
#endif
#ifndef REP_MOE
#define REP_MOE 1
#endif
#ifndef REP_PRO
#define REP_PRO 1
#endif
#ifndef REP_NA
#define REP_NA 1
#endif
#ifndef REP_ABL
#define REP_ABL 0
#endif
#ifndef ABLV
#define ABLV 0
#endif
#ifndef DENSE_FP8
#define DENSE_FP8 15
#endif
#ifndef REP_DENSE
#define REP_DENSE 1
#endif
#define LAS __attribute__((address_space(3)))
#define GAS __attribute__((address_space(1)))
typedef unsigned short bf16_t;
typedef short bf16x8 __attribute__((ext_vector_type(8)));
typedef short s16x4 __attribute__((ext_vector_type(4)));
typedef float f32x2 __attribute__((ext_vector_type(2)));
typedef float f32x4 __attribute__((ext_vector_type(4)));
typedef float f32x16 __attribute__((ext_vector_type(16)));
typedef unsigned u32x2 __attribute__((ext_vector_type(2)));
typedef unsigned u32x4 __attribute__((ext_vector_type(4)));

constexpr int DM = 1024, BATCH = 2, SEQ = 16384, NLAT = BATCH * SEQ, CTXL = 256, NCTX = BATCH * CTXL, NTOK = NLAT + NCTX;
constexpr int NE = 32, FF = 1024, MAXTILES = 552, GRIDW = 64;
constexpr float NORM_EPS = 1e-6f, DIFF_EPS = 1e-5f, LOG2E = 1.4426950408889634f, QSCALE = 0.125f * 1.4426950408889634f;
constexpr float LAMBDA_INIT = 0.3555090675909693f;
constexpr float SWIGLU_LIMIT = 7.0f, SWIGLU_ALPHA = 1.702f;

constexpr size_t MiB = 1u << 20;
constexpr size_t WS_CTL = 0, CTL_ZERO_BYTES = 1 * MiB;
constexpr size_t WS_MOD = 1 * MiB;
constexpr size_t WS_WRT = 1 * MiB + 512 * 1024;
constexpr size_t WS_ROPE = 2 * MiB;
constexpr size_t WS_WQKV = 8 * MiB;
constexpr size_t WS_WO = 20 * MiB;
constexpr size_t WS_WGU = 24 * MiB;
constexpr size_t WS_WDN = 280 * MiB;
constexpr size_t WS_XS = 408 * MiB;
constexpr size_t WS_XN = 538 * MiB;
constexpr size_t WS_Q = 603 * MiB, WS_K = 668 * MiB, WS_V = 733 * MiB, WS_O = 798 * MiB, WS_T = 863 * MiB;
constexpr size_t WS_ACT = 928 * MiB;
constexpr size_t WS_Y = 1204 * MiB;
constexpr size_t WS_TOKOF = 1480 * MiB;
constexpr size_t WS_SLOT = 1485 * MiB;
constexpr size_t WS_GATE = 1486 * MiB;
constexpr size_t WS_XN8 = 1487 * MiB;
constexpr size_t WS_END = 1520 * MiB;
static_assert((size_t)NTOK * DM * 4 == 130 * MiB && (size_t)NTOK * DM * 2 == 65 * MiB && (size_t)MAXTILES * 256 * DM * 2 == 276 * MiB, "ws map");
constexpr int CW_BAR = 4096;
constexpr int CW_CNT = 8192;

constexpr int RING_BYTES = 131072;
constexpr int TAB_OFF = RING_BYTES;
constexpr int MISC_OFF = RING_BYTES + 12288;
constexpr int LDS_BYTES = 147456;

__device__ __forceinline__ unsigned cvt_pk_bf16(float lo, float hi) { unsigned r; asm volatile("v_cvt_pk_bf16_f32 %0, %1, %2" : "=v"(r) : "v"(lo), "v"(hi)); return r; }
__device__ __forceinline__ float bflo(unsigned w) { return __uint_as_float(w << 16); }
__device__ __forceinline__ float bfhi(unsigned w) { return __uint_as_float(w & 0xffff0000u); }
#define DPPF(x, ctrl, rmask, oldv) __builtin_bit_cast(float, __builtin_amdgcn_update_dpp(__builtin_bit_cast(int, (float)(oldv)), __builtin_bit_cast(int, (float)(x)), ctrl, rmask, 0xF, false))
__device__ __forceinline__ float wave_sum(float v) {
    v += DPPF(v, 0xB1, 0xF, 0.f); v += DPPF(v, 0x4E, 0xF, 0.f); v += DPPF(v, 0x141, 0xF, 0.f); v += DPPF(v, 0x140, 0xF, 0.f);
    v += DPPF(v, 0x142, 0xA, 0.f); v += DPPF(v, 0x143, 0xC, 0.f);
    return __builtin_bit_cast(float, __builtin_amdgcn_readlane(__builtin_bit_cast(int, v), 63));
}
__device__ __forceinline__ float wave_max(float v) {
    v = fmaxf(v, DPPF(v, 0xB1, 0xF, v)); v = fmaxf(v, DPPF(v, 0x4E, 0xF, v)); v = fmaxf(v, DPPF(v, 0x141, 0xF, v)); v = fmaxf(v, DPPF(v, 0x140, 0xF, v));
    v = fmaxf(v, DPPF(v, 0x142, 0xA, v)); v = fmaxf(v, DPPF(v, 0x143, 0xC, v));
    return __builtin_bit_cast(float, __builtin_amdgcn_readlane(__builtin_bit_cast(int, v), 63));
}
#define LDS_WAIT() asm volatile("s_waitcnt lgkmcnt(0)" ::: "memory")
#define VM_WAIT() asm volatile("s_waitcnt vmcnt(0)" ::: "memory")

namespace pg8 {
constexpr int BM = 256, BK = 64, HALF = 128, HTB = HALF * BK * 2, STAGE_BYTES = 8 * HTB, NXCD = 8, WGM = 8;
__host__ __device__ __forceinline__ int lds_byte(int r, int c) { const int st = (r >> 4) * 2 + (c >> 5), rr = r & 15, cc = c & 31, ob = rr * 64 + cc * 2; return st * 1024 + (ob ^ (((ob >> 9) & 1) << 5)); }
__host__ __device__ __forceinline__ void stage_rc(int b, int& R, int& C) { const int st = b / 1024, sb = b % 1024, swz = sb ^ (((sb >> 9) & 1) << 5); R = (st >> 1) * 16 + swz / 64; C = (st & 1) * 32 + (swz % 64) / 2; }
__host__ __device__ __forceinline__ int perm32(int rho) { const int n = rho >> 4, i = rho & 15; return 8 * (i >> 2) + 4 * n + (i & 3); }

struct Unit { int pm, pn, e; };

struct DenseOrder {
    int nM, nN, nwg, G, c;
    __device__ void init(int nM_, int nN_, int G_, int c_) { nM = nM_; nN = nN_; nwg = nM * nN; G = G_; c = c_; }
    __device__ bool next(int i, Unit& u) const {
        const long L = (long)i * G + c; if (L >= nwg) return false;
        int wgid = (int)L; { const int q = nwg / NXCD, r = nwg % NXCD, xcd = wgid % NXCD, off = wgid / NXCD; wgid = (xcd < r ? xcd * (q + 1) : r * (q + 1) + (xcd - r) * q) + off; }
        const int nig = WGM * nN, gid = wgid / nig, fm = gid * WGM, gsz = (nM - fm) < WGM ? (nM - fm) : WGM;
        u.pm = fm + ((wgid % nig) % gsz); u.pn = (wgid % nig) / gsz; u.e = 0; return true;
    }
};
struct MoeOrder {
    int nM, nN, nwg, G, c; const LAS int* tile_e;
    __device__ void init(int nM_, int nN_, int G_, int c_, const LAS int* te) { nM = nM_; nN = nN_; nwg = nM * nN; G = G_; c = c_; tile_e = te; }
    __device__ bool next(int i, Unit& u) const {
        const long L = (long)i * G + c; if (L >= nwg) return false;
        int wgid = (int)L; { const int q = nwg / NXCD, r = nwg % NXCD, xcd = wgid % NXCD, off = wgid / NXCD; wgid = (xcd < r ? xcd * (q + 1) : r * (q + 1) + (xcd - r) * q) + off; }
        const int nig = WGM * nN, gid = wgid / nig, fm = gid * WGM, gsz = (nM - fm) < WGM ? (nM - fm) : WGM;
        u.pm = fm + ((wgid % nig) % gsz); u.pn = (wgid % nig) / gsz; u.e = tile_e[u.pm]; return true;
    }
};
struct RowDense { static constexpr bool LOADS = false; __device__ __forceinline__ unsigned row(const Unit& u, int r) const { return (unsigned)(u.pm * BM + r); } };
struct RowMoe {
    static constexpr bool LOADS = true; const int* tokof; const LAS int* cnt; const LAS int* tstart;
    __device__ __forceinline__ unsigned row(const Unit& u, int r) const { const int pos = (u.pm - tstart[u.e]) * BM + r; return pos < cnt[u.e] ? (unsigned)tokof[u.e * NTOK + pos] : 0u; }
};

struct EpiQKV {
    static constexpr bool PERM = true;
    bf16_t* Q; size_t split_stride; float qscale; const float* rope; float ascale;
    __device__ __forceinline__ void operator()(const f32x4 (&acc)[2][2][4][2], const Unit& u, int wr, int wc, int fr, int fq) const {
        const int t = u.pn >> 2, colt = (u.pn & 3) * BM;
        bf16_t* base = Q + (size_t)t * split_stride;
        const float sc = (t == 0) ? qscale : 1.f;
        const int row0 = u.pm * BM + wr * 64 + fr, col0 = colt + wc * 32 + 8 * fq;
        const bool do_rope = (rope != nullptr) && (t < 2) && (u.pm < NLAT / BM), f8qk = (rope != nullptr);
#pragma unroll
        for (int ai = 0; ai < 2; ++ai)
#pragma unroll
            for (int m = 0; m < 4; ++m) {
                const int row = row0 + ai * HALF + m * 16;
                bf16_t* rowp = base + (size_t)row * DM + col0;
#pragma unroll
                for (int bj = 0; bj < 2; ++bj) {
                    f32x4 v0 = acc[ai][bj][m][0] * ascale, v1 = acc[ai][bj][m][1] * ascale;
                    if (do_rope) {
                        const int tpos = row & (SEQ - 1), j0 = ((col0 + bj * HALF) & 63) >> 1;
                        const f32x4 cs0 = *(const f32x4*)(rope + ((size_t)tpos * 32 + j0) * 2), cs1 = *(const f32x4*)(rope + ((size_t)tpos * 32 + j0 + 2) * 2);
                        f32x4 w0, w1;
                        w0[0] = v0[0] * cs0[0] - v0[1] * cs0[1]; w0[1] = v0[0] * cs0[1] + v0[1] * cs0[0];
                        w0[2] = v0[2] * cs0[2] - v0[3] * cs0[3]; w0[3] = v0[2] * cs0[3] + v0[3] * cs0[2];
                        w1[0] = v1[0] * cs1[0] - v1[1] * cs1[1]; w1[1] = v1[0] * cs1[1] + v1[1] * cs1[0];
                        w1[2] = v1[2] * cs1[2] - v1[3] * cs1[3]; w1[3] = v1[2] * cs1[3] + v1[3] * cs1[2];
                        v0 = w0; v1 = w1;
                    }
                    if (f8qk && t < 2) {
                        const float s8 = (t == 0) ? LOG2E * 0.35355339059f : 0.35355339059f; v0 = v0 * s8; v1 = v1 * s8;
                        int w0 = __builtin_amdgcn_cvt_pk_fp8_f32(v0[0], v0[1], 0, false); w0 = __builtin_amdgcn_cvt_pk_fp8_f32(v0[2], v0[3], w0, true);
                        int w1 = __builtin_amdgcn_cvt_pk_fp8_f32(v1[0], v1[1], 0, false); w1 = __builtin_amdgcn_cvt_pk_fp8_f32(v1[2], v1[3], w1, true);
                        *(u32x2*)((unsigned char*)base + (size_t)row * DM + col0 + bj * HALF) = (u32x2){(unsigned)w0, (unsigned)w1};
                    } else {
                    v0 = v0 * sc; v1 = v1 * sc;
                    u32x4 w; w.x = cvt_pk_bf16(v0[0], v0[1]); w.y = cvt_pk_bf16(v0[2], v0[3]); w.z = cvt_pk_bf16(v1[0], v1[1]); w.w = cvt_pk_bf16(v1[2], v1[3]);
                    *(u32x4*)(rowp + bj * HALF) = w; }
                }
            }
    }
};
struct EpiPlain {
    static constexpr bool PERM = true;
    bf16_t* O; const float* bias; float ascale;
    __device__ __forceinline__ void operator()(const f32x4 (&acc)[2][2][4][2], const Unit& u, int wr, int wc, int fr, int fq) const {
        const int row0 = u.pm * BM + wr * 64 + fr, col0 = u.pn * BM + wc * 32 + 8 * fq;
        f32x4 bv[2][2];
#pragma unroll
        for (int bj = 0; bj < 2; ++bj)
#pragma unroll
            for (int n = 0; n < 2; ++n) bv[bj][n] = bias ? *(const f32x4*)(bias + (size_t)u.e * DM + col0 + bj * HALF + 4 * n) : (f32x4){0.f, 0.f, 0.f, 0.f};
#pragma unroll
        for (int ai = 0; ai < 2; ++ai)
#pragma unroll
            for (int m = 0; m < 4; ++m) {
                bf16_t* rowp = O + (size_t)(row0 + ai * HALF + m * 16) * DM + col0;
#pragma unroll
                for (int bj = 0; bj < 2; ++bj) {
                    const f32x4 v0 = acc[ai][bj][m][0] * ascale + bv[bj][0], v1 = acc[ai][bj][m][1] * ascale + bv[bj][1];
                    u32x4 w; w.x = cvt_pk_bf16(v0[0], v0[1]); w.y = cvt_pk_bf16(v0[2], v0[3]); w.z = cvt_pk_bf16(v1[0], v1[1]); w.w = cvt_pk_bf16(v1[2], v1[3]);
                    *(u32x4*)(rowp + bj * HALF) = w;
                }
            }
    }
};
__device__ __forceinline__ float swiglu1(float g, float u) {
    g = fminf(g, SWIGLU_LIMIT); u = fminf(fmaxf(u, -SWIGLU_LIMIT), SWIGLU_LIMIT);
    const float sg = __builtin_amdgcn_rcpf(1.f + __builtin_amdgcn_exp2f(-SWIGLU_ALPHA * LOG2E * g));
    return (u + 1.f) * (g * sg);
}
__device__ __forceinline__ f32x2 swiglu2(f32x2 g, f32x2 u) {
    g = (f32x2){fminf(g[0], SWIGLU_LIMIT), fminf(g[1], SWIGLU_LIMIT)};
    u = (f32x2){fminf(fmaxf(u[0], -SWIGLU_LIMIT), SWIGLU_LIMIT), fminf(fmaxf(u[1], -SWIGLU_LIMIT), SWIGLU_LIMIT)};
    const f32x2 z = g * (f32x2){-SWIGLU_ALPHA * LOG2E, -SWIGLU_ALPHA * LOG2E};
    const f32x2 d = (f32x2){__builtin_amdgcn_exp2f(z[0]), __builtin_amdgcn_exp2f(z[1])} + (f32x2){1.f, 1.f};
    const f32x2 sg = (f32x2){__builtin_amdgcn_rcpf(d[0]), __builtin_amdgcn_rcpf(d[1])};
    return (u + (f32x2){1.f, 1.f}) * (g * sg);
}
struct EpiSwiGLU {
    static constexpr bool PERM = true;
    unsigned char* ACT8p; const float* bgu;
    __device__ __forceinline__ void operator()(const f32x4 (&acc)[2][2][4][2], const Unit& u, int wr, int wc, int fr, int fq) const {
        const int row0 = u.pm * BM + wr * 64 + fr, cj = u.pn * HALF + wc * 32 + 8 * fq;
        f32x4 bg[2], bu[2];
#pragma unroll
        for (int n = 0; n < 2; ++n) { bg[n] = *(const f32x4*)(bgu + (size_t)u.e * 2048 + cj + 4 * n); bu[n] = *(const f32x4*)(bgu + (size_t)u.e * 2048 + 1024 + cj + 4 * n); }
#pragma unroll
        for (int ai = 0; ai < 2; ++ai)
#pragma unroll
            for (int m = 0; m < 4; ++m) {
                unsigned char* rowp = ACT8p + (size_t)(row0 + ai * HALF + m * 16) * DM + cj;
                const f32x4 g0 = acc[ai][0][m][0] * 0.03125f + bg[0], g1 = acc[ai][0][m][1] * 0.03125f + bg[1], u0 = acc[ai][1][m][0] * 0.03125f + bu[0], u1 = acc[ai][1][m][1] * 0.03125f + bu[1];
                const f32x2 s00 = swiglu2((f32x2){g0[0], g0[1]}, (f32x2){u0[0], u0[1]}), s01 = swiglu2((f32x2){g0[2], g0[3]}, (f32x2){u0[2], u0[3]});
                const f32x2 s10 = swiglu2((f32x2){g1[0], g1[1]}, (f32x2){u1[0], u1[1]}), s11 = swiglu2((f32x2){g1[2], g1[3]}, (f32x2){u1[2], u1[3]});
                int w0 = __builtin_amdgcn_cvt_pk_fp8_f32(s00[0], s00[1], 0, false); w0 = __builtin_amdgcn_cvt_pk_fp8_f32(s01[0], s01[1], w0, true);
                int w1 = __builtin_amdgcn_cvt_pk_fp8_f32(s10[0], s10[1], 0, false); w1 = __builtin_amdgcn_cvt_pk_fp8_f32(s11[0], s11[1], w1, true);
                *(u32x2*)rowp = (u32x2){(unsigned)w0, (unsigned)w1};
            }
    }
};

__device__ __forceinline__ void glds16s(const void* sbase, unsigned voff, unsigned lds_dst) {
    unsigned keep;
    asm volatile("s_mov_b32 %0, m0\n\ts_mov_b32 m0, %3\n\ts_nop 0\n\tglobal_load_lds_dwordx4 %1, %2\n\ts_mov_b32 m0, %0" : "=&s"(keep) : "v"(voff), "s"(sbase), "s"(lds_dst) : "memory");
}
template <int ES, class Epi, class Sched, class RowMap>
__device__ __forceinline__ void gemm_phase(LAS unsigned char* lds, const void* A, const void* Bt, int K, size_t b_estride, const Sched& S, const Epi& E, const RowMap& RM) {
    typedef int v8i_t __attribute__((ext_vector_type(8))); typedef int v4i_t __attribute__((ext_vector_type(4)));
    constexpr int sclB = 0, sclA = 0;
    int tid = threadIdx.x; asm volatile("" : "+v"(tid));
    const int wid = __builtin_amdgcn_readfirstlane(tid >> 6), lane = tid & 63, wr = wid >> 2, wc = wid & 3, fr = lane & 15, fq = lane >> 4;
    const int nt = K * ES / (BK * 2);
    unsigned voffB[2];
#pragma unroll
    for (int i = 0; i < 2; ++i) { int R, C; stage_rc(tid * 16 + i * 8192, R, C); const int Rb = Epi::PERM ? ((R & ~31) + perm32(R & 31)) : R; voffB[i] = (unsigned)(Rb * K * ES + C * 2); }
    const unsigned kstep = (unsigned)(BK * 2);
    const size_t hstep = (size_t)HALF * K * ES, tstep = 2 * hstep;
    const unsigned ldsw = (unsigned)wid * 1024u, lds0 = (unsigned)(uintptr_t)lds;
    const int aoff = lds_byte(wr * 64 + fr, fq * 8), boff = lds_byte(wc * 32 + fr, fq * 8);
#define PG8_SA(b, h) (((b) * 2 + (h)) * HTB)
#define PG8_SB(b, h) ((4 + (b) * 2 + (h)) * HTB)
#define PG8_STAGE_B(bufoff, gbase) do { _Pragma("unroll") for (int _i = 0; _i < 2; ++_i) \
        glds16s((const char*)(gbase), voffB[_i], (unsigned)__builtin_amdgcn_readfirstlane((int)(lds0 + (bufoff) + ldsw + _i * 8192))); } while (0)
#define PG8_STAGE_A(bufoff, offs, kb) do { _Pragma("unroll") for (int _i = 0; _i < 2; ++_i) \
        glds16s((const char*)A + (kb), (offs)[_i], (unsigned)__builtin_amdgcn_readfirstlane((int)(lds0 + (bufoff) + ldsw + _i * 8192))); } while (0)
#define PG8_LDA(dst, b, h) do { _Pragma("unroll") for (int m = 0; m < 4; ++m) _Pragma("unroll") for (int k = 0; k < 2; ++k) dst[m][k] = *(const LAS bf16x8*)(lds + PG8_SA(b, h) + aoff + m * 2048 + k * 1024); } while (0)
#define PG8_LDB(dst, b, h) do { _Pragma("unroll") for (int n = 0; n < 2; ++n) _Pragma("unroll") for (int k = 0; k < 2; ++k) dst[n][k] = *(const LAS bf16x8*)(lds + PG8_SB(b, h) + boff + n * 2048 + k * 1024); } while (0)
#define PG8_CAT(x0, x1) __builtin_shufflevector(__builtin_bit_cast(v4i_t, x0), __builtin_bit_cast(v4i_t, x1), 0, 1, 2, 3, 4, 5, 6, 7)
#define PG8_MMA(ai, bj, At, Bt_) do { __builtin_amdgcn_s_setprio(1); \
        if constexpr (ES == 2) { _Pragma("unroll") for (int m = 0; m < 4; ++m) _Pragma("unroll") for (int n = 0; n < 2; ++n) _Pragma("unroll") for (int k = 0; k < 2; ++k) \
            acc[ai][bj][m][n] = __builtin_amdgcn_mfma_f32_16x16x32_bf16(Bt_[n][k], At[m][k], acc[ai][bj][m][n], 0, 0, 0); } \
        else { _Pragma("unroll") for (int m = 0; m < 4; ++m) _Pragma("unroll") for (int n = 0; n < 2; ++n) \
            acc[ai][bj][m][n] = __builtin_amdgcn_mfma_scale_f32_16x16x128_f8f6f4(PG8_CAT(Bt_[n][0], Bt_[n][1]), PG8_CAT(At[m][0], At[m][1]), acc[ai][bj][m][n], 0, 0, 0, sclB, 0, sclA); } \
        __builtin_amdgcn_s_setprio(0); } while (0)
#define PG8_WAIT_V(n) asm volatile("s_waitcnt vmcnt(" #n ")" ::: "memory")
#define PG8_WAIT_L(n) asm volatile("s_waitcnt lgkmcnt(" #n ")" ::: "memory")
#define PG8_BAR __builtin_amdgcn_s_barrier()
#define PG8_SCHED __builtin_amdgcn_sched_barrier(0)
#define PG8_AOFF(dst, u) do { int t_ = tid; asm volatile("" : "+v"(t_)); _Pragma("unroll") for (int _i = 0; _i < 2; ++_i) { int R_, C_; stage_rc(t_ * 16 + _i * 8192, R_, C_); \
        _Pragma("unroll") for (int _h = 0; _h < 2; ++_h) dst[_h][_i] = RM.row(u, _h * HALF + R_) * (unsigned)(K * ES) + (unsigned)C_ * 2u; } } while (0)
#define PG8_ARAW(dst, u) do { int t_ = tid; asm volatile("" : "+v"(t_)); _Pragma("unroll") for (int _i = 0; _i < 2; ++_i) { int R_, C_; stage_rc(t_ * 16 + _i * 8192, R_, C_); \
        _Pragma("unroll") for (int _h = 0; _h < 2; ++_h) dst[_h][_i] = RM.row(u, _h * HALF + R_); } } while (0)
#define PG8_AFIN(dst, raw) do { int t_ = tid; asm volatile("" : "+v"(t_)); _Pragma("unroll") for (int _i = 0; _i < 2; ++_i) { int R_, C_; stage_rc(t_ * 16 + _i * 8192, R_, C_); \
        _Pragma("unroll") for (int _h = 0; _h < 2; ++_h) dst[_h][_i] = raw[_h][_i] * (unsigned)(K * ES) + (unsigned)C_ * 2u; } } while (0)
    Unit cur, nxt, nn; int ui = 0;
    if (!S.next(0, cur)) return;
    bool has_next = S.next(1, nxt);
    unsigned offc[2][2], offn[2][2];
    PG8_AOFF(offc, cur);
    if (has_next) PG8_AOFF(offn, nxt); else { _Pragma("unroll") for (int h = 0; h < 2; ++h) _Pragma("unroll") for (int i = 0; i < 2; ++i) offn[h][i] = offc[h][i]; }
    if (RowMap::LOADS) { PG8_WAIT_V(0); PG8_WAIT_L(0); }
    f32x4 acc[2][2][4][2];
#pragma unroll
    for (int a = 0; a < 2; ++a)
#pragma unroll
        for (int b = 0; b < 2; ++b)
#pragma unroll
            for (int m = 0; m < 4; ++m)
#pragma unroll
                for (int n = 0; n < 2; ++n) acc[a][b][m][n] = (f32x4){0.f, 0.f, 0.f, 0.f};
    bf16x8 At[4][2], B0[2][2], B1[2][2];
    const char* cB = (const char*)Bt + (size_t)cur.e * b_estride + (size_t)cur.pn * tstep;
    PG8_STAGE_B(PG8_SB(0, 0), cB); PG8_STAGE_B(PG8_SB(0, 1), cB + hstep); PG8_STAGE_A(PG8_SA(0, 0), offc[0], 0u); PG8_STAGE_A(PG8_SA(0, 1), offc[1], 0u);
    if (wr == 1) PG8_BAR;
    PG8_WAIT_V(2); PG8_BAR;
    PG8_STAGE_B(PG8_SB(1, 0), cB + kstep); PG8_STAGE_A(PG8_SA(1, 0), offc[0], kstep); PG8_STAGE_B(PG8_SB(1, 1), cB + hstep + kstep);
    PG8_WAIT_V(6); PG8_BAR;
    for (;;) {
        const char* nB = has_next ? (const char*)Bt + (size_t)nxt.e * b_estride + (size_t)nxt.pn * tstep : cB;
        for (int t = 0; t < nt; t += 2) {
            const bool last = (t == nt - 2);
            const unsigned kb1 = (unsigned)(t + 1) * kstep, kb2 = last ? 0u : (unsigned)(t + 2) * kstep, kb3 = kb2 + kstep;
#define PG8_STAGE_A2(bufoff, h, kb) do { if (last) PG8_STAGE_A(bufoff, offn[h], kb); else PG8_STAGE_A(bufoff, offc[h], kb); } while (0)
            const char* b2 = last ? nB : cB + (size_t)(t + 2) * kstep; const char* b3 = b2 + kstep;
            PG8_LDB(B0, 0, 0); PG8_LDB(B1, 0, 1); PG8_SCHED; PG8_LDA(At, 0, 0); PG8_STAGE_A(PG8_SA(1, 1), offc[1], kb1);
            PG8_WAIT_V(8); PG8_WAIT_L(0); PG8_BAR; PG8_MMA(0, 0, At, B0); PG8_MMA(0, 1, At, B1); PG8_BAR; PG8_SCHED;
            PG8_LDA(At, 0, 1); PG8_STAGE_B(PG8_SB(0, 0), b2); PG8_STAGE_B(PG8_SB(0, 1), b2 + hstep); PG8_STAGE_A2(PG8_SA(0, 0), 0, kb2);
            PG8_WAIT_V(8); PG8_WAIT_L(0); PG8_BAR; PG8_MMA(1, 0, At, B0); PG8_MMA(1, 1, At, B1); PG8_BAR; PG8_SCHED;
            PG8_LDB(B0, 1, 0); PG8_LDB(B1, 1, 1); PG8_SCHED; PG8_LDA(At, 1, 0); PG8_STAGE_A2(PG8_SA(0, 1), 1, kb2);
            PG8_WAIT_V(8); PG8_WAIT_L(0); PG8_BAR; PG8_MMA(0, 0, At, B0); PG8_MMA(0, 1, At, B1); PG8_BAR; PG8_SCHED;
            PG8_LDA(At, 1, 1); PG8_STAGE_B(PG8_SB(1, 0), b3); PG8_STAGE_B(PG8_SB(1, 1), b3 + hstep); PG8_STAGE_A2(PG8_SA(1, 0), 0, kb3);
            PG8_WAIT_V(8); PG8_WAIT_L(0); PG8_BAR; PG8_MMA(1, 0, At, B0); PG8_MMA(1, 1, At, B1); PG8_BAR; PG8_SCHED;
        }
        const bool has_nn = has_next && S.next(ui + 2, nn);
#pragma unroll
        for (int h = 0; h < 2; ++h)
#pragma unroll
            for (int i = 0; i < 2; ++i) offc[h][i] = offn[h][i];
        unsigned rawn[2][2];
        if (has_nn) { if constexpr (RowMap::LOADS) PG8_ARAW(rawn, nn); else PG8_AOFF(offn, nn); }
        if (wr == 0) PG8_BAR;
        E(acc, cur, wr, wc, fr, fq);
        if constexpr (RowMap::LOADS) { if (has_nn) PG8_AFIN(offn, rawn); PG8_WAIT_V(0); PG8_WAIT_L(0); }
        if (!has_next) break;
#pragma unroll
        for (int a = 0; a < 2; ++a)
#pragma unroll
            for (int b = 0; b < 2; ++b)
#pragma unroll
                for (int m = 0; m < 4; ++m)
#pragma unroll
                    for (int n = 0; n < 2; ++n) acc[a][b][m][n] = (f32x4){0.f, 0.f, 0.f, 0.f};
        cur = nxt; cB = nB; nxt = nn; has_next = has_nn; ++ui;
        if (wr == 1) PG8_BAR;
    }
    PG8_WAIT_V(0);
    PG8_BAR;
#undef PG8_SA
#undef PG8_SB
#undef PG8_STAGE_A
#undef PG8_STAGE_A2
#undef PG8_STAGE_B
#undef PG8_LDA
#undef PG8_LDB
#undef PG8_MMA
#undef PG8_CAT
#undef PG8_WAIT_V
#undef PG8_WAIT_L
#undef PG8_BAR
#undef PG8_SCHED
#undef PG8_AOFF
#undef PG8_ARAW
#undef PG8_AFIN
}
}

namespace att {
constexpr int NW = 8, QBLK = 32, KVBLK = 64, LD = DM;
constexpr float THRL = 8.f;
#define KSWZ64(row, colB) ((row) * 128 + ((colB) ^ ((((row) >> 1) & 7) << 4)))
#define SBAR() __builtin_amdgcn_sched_barrier(0)
__device__ __forceinline__ int crow(int r, int hi) { return (r & 3) + 8 * (r >> 2) + 4 * hi; }
template <int NCB> __device__ __forceinline__ int v_st(int k, int c) { const int kk = (k & ~0xC) | ((k & 4) << 1) | ((k & 8) >> 1); return ((kk >> 3) * NCB + (c >> 5)) * 512 + ((kk & 7) * 32 + (c & 31)) * 2; }
__device__ __forceinline__ int v_rd_base(int lane) { return ((lane & 3) << 3) | (((lane >> 2) & 3) << 6) | (((lane >> 4) & 1) << 5) | (((lane >> 5) & 1) << 8); }
template <int OFF> __device__ __forceinline__ s16x4 tr_read(int vb) { s16x4 r; asm volatile("ds_read_b64_tr_b16 %0, %1 offset:%2" : "=&v"(r) : "v"(vb), "i"(OFF) : "memory"); return r; }
template <int NCB, int D0> __device__ __forceinline__ void pv_one(f32x16& od, int vb, bf16x8 pa0, bf16x8 pa1, bf16x8 pa2, bf16x8 pa3) {
    constexpr int G = NCB * 512;
    const s16x4 l0 = tr_read<D0 * 512 + 0 * G>(vb), h0 = tr_read<D0 * 512 + 1 * G>(vb), l1 = tr_read<D0 * 512 + 2 * G>(vb), h1 = tr_read<D0 * 512 + 3 * G>(vb);
    const s16x4 l2 = tr_read<D0 * 512 + 4 * G>(vb), h2 = tr_read<D0 * 512 + 5 * G>(vb), l3 = tr_read<D0 * 512 + 6 * G>(vb), h3 = tr_read<D0 * 512 + 7 * G>(vb);
    asm volatile("s_waitcnt lgkmcnt(0)" ::: "memory"); SBAR();
#define PK(L, H) (bf16x8){L[0], L[1], L[2], L[3], H[0], H[1], H[2], H[3]}
    od = __builtin_amdgcn_mfma_f32_32x32x16_bf16(pa0, PK(l0, h0), od, 0, 0, 0);
    od = __builtin_amdgcn_mfma_f32_32x32x16_bf16(pa1, PK(l1, h1), od, 0, 0, 0);
    od = __builtin_amdgcn_mfma_f32_32x32x16_bf16(pa2, PK(l2, h2), od, 0, 0, 0);
    od = __builtin_amdgcn_mfma_f32_32x32x16_bf16(pa3, PK(l3, h3), od, 0, 0, 0);
#undef PK
}
template <int DV> struct Lay { static constexpr int NCB = DV / 32, SHM_K = 8192, SHM_V = 64 * DV * 2, OFF_V = 2 * SHM_K, OFF_WS = OFF_V + 2 * SHM_V, OFF_BIAS = OFF_WS + NW * 256, END = OFF_BIAS + 2048; };

template <int DV, bool NA, class BG>
__device__ __forceinline__ void attn_run(f32x16 (&o)[DV / 32], const bf16_t* Qw, const bf16_t* Kh, const bf16_t* Vh, int row_first, int n_main, int ctx_row, int n_ctx,
                                         char* lds, int jlo, int drbase, int qcol, BG& bg  ) {
    using L = Lay<DV>; constexpr int NCB = L::NCB;
    int tid = threadIdx.x; asm volatile("" : "+v"(tid));
    const int wid = __builtin_amdgcn_readfirstlane(tid >> 6), lane = tid & 63, r32 = lane & 31, hi = lane >> 5;
    char* K_lds = lds; char* V_lds = lds + L::OFF_V;
    float* wsf = (float*)(lds + L::OFF_WS) + wid * 64; const float* bias_l = (const float*)(lds + L::OFF_BIAS);
    float m_reg = 0.f, l_reg = 0.f; bool first = true; f32x16 negm = f32x16{};
#pragma unroll
    for (int d = 0; d < NCB; ++d) o[d] = f32x16{};
    bf16x8 qr[4];
#pragma unroll
    for (int d0 = 0; d0 < 4; ++d0) qr[d0] = *reinterpret_cast<const bf16x8*>(Qw + (size_t)r32 * LD + d0 * 16 + hi * 8);
    const int ksr = tid >> 3, ksc = (tid & 7) * 8;
    const int vsr = (DV == 128) ? (tid >> 4) : (tid >> 3), vsc = (DV == 128) ? (tid & 15) * 8 : (tid & 7) * 8;
    const int vst0 = v_st<NCB>(vsr, vsc), vst1 = v_st<NCB>(32 + vsr, vsc);
    const int vb0 = (int)(uintptr_t)V_lds + v_rd_base(lane);
    const int NT = n_main + n_ctx;
    bf16x8 ksA, vsA0, vsA1, ksB, vsB0, vsB1;
#define TROW(j) ((j) < n_main ? row_first + (j) * KVBLK : ctx_row + ((j) - n_main) * KVBLK)
#define SLOAD(j, KS, VS0, VS1) do { const size_t r_ = (size_t)TROW(j); KS = *reinterpret_cast<const bf16x8*>(Kh + (r_ + ksr) * LD + ksc); \
        VS0 = *reinterpret_cast<const bf16x8*>(Vh + (r_ + vsr) * LD + vsc); if (DV == 128) VS1 = *reinterpret_cast<const bf16x8*>(Vh + (r_ + 32 + vsr) * LD + vsc); } while (0)
#define SWRITE(b, KS, VS0, VS1) do { *(bf16x8*)(K_lds + (b) * L::SHM_K + KSWZ64(ksr, ksc * 2)) = KS; *(bf16x8*)(V_lds + (b) * L::SHM_V + vst0) = VS0; \
        if (DV == 128) *(bf16x8*)(V_lds + (b) * L::SHM_V + vst1) = VS1; } while (0)
    auto compute = [&](const int j, const int b) __attribute__((always_inline)) {
        const bool part = NA ? (j >= n_main || (j >= jlo && j < jlo + 8)) : true;
        if (part) {
            f32x16 p0 = negm, p1 = negm;
            const char* Kb = K_lds + b * L::SHM_K;
#pragma unroll
            for (int d0 = 0; d0 < 4; ++d0) { const int cb = (d0 * 16 + hi * 8) * 2;
                const bf16x8 b0 = *reinterpret_cast<const bf16x8*>(Kb + KSWZ64(r32, cb));
                const bf16x8 b1 = *reinterpret_cast<const bf16x8*>(Kb + KSWZ64(32 + r32, cb));
                p0 = __builtin_amdgcn_mfma_f32_32x32x16_bf16(b0, qr[d0], p0, 0, 0, 0);
                p1 = __builtin_amdgcn_mfma_f32_32x32x16_bf16(b1, qr[d0], p1, 0, 0, 0); }
            if (NA && j < n_main) {
                const int c0 = min(max(qcol - 8, 0), GRIDW - 16), dr = drbase + j, sh = 15 - qcol;
                const LAS float* brow = (const LAS float*)(uintptr_t)(unsigned)(uintptr_t)bias_l + dr * 32;
                float bv0[16], bv1[16];
#pragma unroll
                for (int r = 0; r < 16; ++r) { const int cc = crow(r, hi), c2 = cc + 32;
                    const int i0 = ((unsigned)(cc - c0) < 16u) ? cc + sh : 31, i1 = ((unsigned)(c2 - c0) < 16u) ? c2 + sh : 31;
                    bv0[r] = brow[i0]; bv1[r] = brow[i1]; }
#pragma unroll
                for (int r = 0; r < 16; ++r) { p0[r] += bv0[r]; p1[r] += bv1[r]; }
            }
            float pmax = p0[0];
#pragma unroll
            for (int r = 1; r < 16; ++r) pmax = fmaxf(pmax, p0[r]);
#pragma unroll
            for (int r = 0; r < 16; ++r) pmax = fmaxf(pmax, p1[r]);
            { auto rr = __builtin_amdgcn_permlane32_swap(__float_as_uint(pmax), __float_as_uint(pmax), false, false); pmax = fmaxf(__uint_as_float(rr[0]), __uint_as_float(rr[1])); }
            float alpha = 1.f;
            if (first || !__all(pmax <= THRL)) { const float dl = first ? pmax : fmaxf(pmax, 0.f); if (!first) alpha = __builtin_amdgcn_exp2f(-dl); m_reg += dl; first = false;
#pragma unroll
                for (int r = 0; r < 16; ++r) { p0[r] -= dl; p1[r] -= dl; }
#pragma unroll
                for (int r = 0; r < 16; ++r) negm[r] = -m_reg;
                asm volatile("" : "+v"(negm)); }
#pragma unroll
            for (int r = 0; r < 16; ++r) { p0[r] = __builtin_amdgcn_exp2f(p0[r]); p1[r] = __builtin_amdgcn_exp2f(p1[r]); }
            float ps = 0.f;
#pragma unroll
            for (int r = 0; r < 16; ++r) ps += p0[r];
#pragma unroll
            for (int r = 0; r < 16; ++r) ps += p1[r];
            { auto rr = __builtin_amdgcn_permlane32_swap(__float_as_uint(ps), __float_as_uint(ps), false, false); ps = __uint_as_float(rr[0]) + __uint_as_float(rr[1]); }
            l_reg = l_reg * alpha + ps;
            bf16x8 pa0, pa1, pa2, pa3;
#define PK4(P, BASE, OUT) do { unsigned a0 = cvt_pk_bf16(P[BASE + 0], P[BASE + 1]), a1 = cvt_pk_bf16(P[BASE + 2], P[BASE + 3]);   \
    unsigned b0_ = cvt_pk_bf16(P[BASE + 4], P[BASE + 5]), b1_ = cvt_pk_bf16(P[BASE + 6], P[BASE + 7]);                              \
    auto r0 = __builtin_amdgcn_permlane32_swap(a0, b0_, false, false); auto r1 = __builtin_amdgcn_permlane32_swap(a1, b1_, false, false); \
    u32x4 w = {r0[0], r1[0], r0[1], r1[1]}; OUT = *reinterpret_cast<bf16x8*>(&w); } while (0)
            PK4(p0, 0, pa0); PK4(p0, 8, pa1); PK4(p1, 0, pa2); PK4(p1, 8, pa3);
#undef PK4
            if (__any(alpha < 1.f)) { if (hi == 0) wsf[r32] = alpha; asm volatile("s_waitcnt lgkmcnt(0)" ::: "memory");
#pragma unroll
                for (int d = 0; d < NCB; ++d)
#pragma unroll
                    for (int r = 0; r < 16; ++r) o[d][r] *= wsf[crow(r, hi)];
                asm volatile("s_waitcnt lgkmcnt(0)" ::: "memory"); }
            const int vb = vb0 + b * L::SHM_V;
            pv_one<NCB, 0>(o[0], vb, pa0, pa1, pa2, pa3); pv_one<NCB, 1>(o[1], vb, pa0, pa1, pa2, pa3);
            if constexpr (NCB == 4) { pv_one<NCB, 2>(o[2], vb, pa0, pa1, pa2, pa3); pv_one<NCB, 3>(o[3], vb, pa0, pa1, pa2, pa3); }
        }
    };
    SLOAD(0, ksA, vsA0, vsA1);
    if (NT > 1) SLOAD(1, ksB, vsB0, vsB1);
    for (int j = 0; j < NT; j += 2) {
        SWRITE(0, ksA, vsA0, vsA1);
        if (j + 2 < NT) SLOAD(j + 2, ksA, vsA0, vsA1);
        __syncthreads();
        compute(j, 0);
        if (j + 1 < NT) {
            SWRITE(1, ksB, vsB0, vsB1);
            if (j + 3 < NT) SLOAD(j + 3, ksB, vsB0, vsB1);
            __syncthreads();
            bg.step();
            compute(j + 1, 1);
        }
    }
    if (hi == 0) wsf[32 + r32] = l_reg; asm volatile("s_waitcnt lgkmcnt(0)" ::: "memory");
#pragma unroll
    for (int r = 0; r < 16; ++r) { const float rl = __builtin_amdgcn_rcpf(wsf[32 + crow(r, hi)]);
#pragma unroll
        for (int d = 0; d < NCB; ++d) o[d][r] *= rl; }
    __syncthreads();
#undef TROW
#undef SLOAD
#undef SWRITE
}

constexpr int DA_KS = 4096, DA_VS = 8192, DA_OFF_V = 4 * DA_KS, DA_OFF_WS = DA_OFF_V + 4 * DA_VS, DA_END = DA_OFF_WS + NW * 256;
constexpr float DA_POFF = 6.f, DA_PLIM = 8.f;
typedef int v8i_t __attribute__((ext_vector_type(8)));
#define DA_WAITBAR(N) asm volatile("s_waitcnt vmcnt(" #N ") lgkmcnt(0)\n\ts_barrier" ::: "memory")
#define DA_LGKM(N) asm volatile("s_waitcnt lgkmcnt(" #N ")" ::: "memory")
template <int ABL>
__device__ __forceinline__ void dattn_run(f32x16 (&o)[4], const unsigned char* Qw8, const unsigned char* Kh8, const unsigned char* Vt8, int row_first, int ctx_row, char* lds) {
    constexpr int NT = SEQ / 64 + CTXL / 64, NMAIN = SEQ / 64;
    int tid = threadIdx.x; asm volatile("" : "+v"(tid));
    const int wid = __builtin_amdgcn_readfirstlane(tid >> 6), lane = tid & 63, r32 = lane & 31, hi = lane >> 5;
    const bool kw = wid < 4;
    LAS unsigned char* ldsl = (LAS unsigned char*)(uintptr_t)(unsigned)(uintptr_t)lds;
    float* wsf = (float*)(lds + DA_OFF_WS) + wid * 64;
    unsigned koff;
    { const int p = (wid & 3) * 64 + lane, key = p >> 2, c = (p & 3) ^ ((key >> 2) & 3); koff = (unsigned)(key * LD + c * 16); }
    const unsigned voff = (unsigned)(wid * 64 + lane) * 16u;
#define DA_TROW(t) ((t) < NMAIN ? row_first + (t) * 64 : ctx_row + ((t) - NMAIN) * 64)
#define DA_DMA_K(t, slot) do { if (kw) { const char* g_ = (const char*)Kh8 + (size_t)DA_TROW(t) * LD; \
        __builtin_amdgcn_global_load_lds((const unsigned*)(g_ + koff), (LAS unsigned*)(ldsl + (slot) * DA_KS + (wid & 3) * 1024), 16, 0, 0); } } while (0)
#define DA_DMA_V(t, slot) do { if (kw) { const char* g_ = (const char*)Vt8 + (size_t)(t) * 8192;     \
        __builtin_amdgcn_global_load_lds((const unsigned*)(g_ + voff), (LAS unsigned*)(ldsl + DA_OFF_V + (slot) * DA_VS + wid * 1024), 16, 0, 0); \
        __builtin_amdgcn_global_load_lds((const unsigned*)(g_ + voff + 4096), (LAS unsigned*)(ldsl + DA_OFF_V + (slot) * DA_VS + wid * 1024 + 4096), 16, 0, 0); } } while (0)
#define DA_WB_STEADY() do { if (kw) DA_WAITBAR(3); else DA_WAITBAR(0); } while (0)
    v8i_t qf;
    { const u32x4 a = *reinterpret_cast<const u32x4*>(Qw8 + (size_t)r32 * LD + hi * 32), b = *reinterpret_cast<const u32x4*>(Qw8 + (size_t)r32 * LD + hi * 32 + 16);
      qf = (v8i_t){(int)a[0], (int)a[1], (int)a[2], (int)a[3], (int)b[0], (int)b[1], (int)b[2], (int)b[3]}; }
    DA_DMA_K(0, 0); DA_DMA_V(0, 0); DA_DMA_K(1, 1); DA_DMA_K(2, 2); DA_DMA_V(1, 1);
    float m_reg = 0.f; f32x16 ol = f32x16{};
#pragma unroll
    for (int d = 0; d < 4; ++d) o[d] = f32x16{};
    const int vsw = (r32 >> 2) & 3;
    const int kb0 = (int)(uintptr_t)lds + r32 * 64 + ((2 * hi) ^ vsw) * 16;
    const int vb0 = (int)(uintptr_t)(lds + DA_OFF_V) + r32 * 64 + ((2 * hi) ^ vsw) * 16, vb1x = 16 - 32 * (((2 * hi) ^ vsw) & 1);
    f32x16 pA0, pA1, pB0, pB1, negm = f32x16{};
    v8i_t pk = (v8i_t){0, 0, 0, 0, 0, 0, 0, 0};
    u32x4 kfa_[2], kfb_[2]; u32x4 vfa_[3], vfb_[3];
    v8i_t ones8; { int o1 = 0x38383838; asm volatile("" : "+s"(o1)); ones8 = (v8i_t){o1, o1, o1, o1, o1, o1, o1, o1}; asm volatile("" : "+v"(ones8)); }
    const int scl1 = 0x7f7f7f7f, sclq = 0x7c7c7c7c;
#define DA_KRD(dst, addr, OFF) asm volatile("ds_read_b128 %0, %1 offset:%2" : "=&v"(dst) : "v"(addr), "i"(OFF) : "memory")
#define DA_KFR(g, ka) do { DA_KRD(kfa_[g], ka, (g) * 2048); DA_KRD(kfb_[g], (ka) + vb1x, (g) * 2048); } while (0)
#define DA_KF8(g) (v8i_t){(int)kfa_[g][0], (int)kfa_[g][1], (int)kfa_[g][2], (int)kfa_[g][3], (int)kfb_[g][0], (int)kfb_[g][1], (int)kfb_[g][2], (int)kfb_[g][3]}
#define DA_QKM(g) __builtin_amdgcn_mfma_scale_f32_32x32x64_f8f6f4(DA_KF8(g), qf, negm, 0, 0, 0, 0, 0, 0)
#define DA_VFR(s, d, vb) do { DA_KRD(vfa_[s], vb, (d) * 2048); DA_KRD(vfb_[s], (vb) + vb1x, (d) * 2048); } while (0)
#define DA_VF8(s) (v8i_t){(int)vfa_[s][0], (int)vfa_[s][1], (int)vfa_[s][2], (int)vfa_[s][3], (int)vfb_[s][0], (int)vfb_[s][1], (int)vfb_[s][2], (int)vfb_[s][3]}
#define DA_PVM(d, s) o[d] = __builtin_amdgcn_mfma_scale_f32_32x32x64_f8f6f4(pk, DA_VF8(s), o[d], 0, 0, 0, 0, 0, 0)
#define DA_C4(P, B, OLD) ({ int t_ = __builtin_amdgcn_cvt_pk_fp8_f32(P[B], P[B + 1], (OLD), false); t_ = __builtin_amdgcn_cvt_pk_fp8_f32(P[B + 2], P[B + 3], t_, true); t_; })
#define DA_ADD4(S, P, B) do { S += P[B]; S += P[B + 1]; S += P[B + 2]; S += P[B + 3]; } while (0)
#define DA_EX(P, r) P[r] = __builtin_amdgcn_exp2f(P[r])
#define DA_PIN(x) asm volatile("" : "+v"(x))
#define DA_SUB16(P, D) asm volatile("v_sub_f32 %0, %0, %16\n\tv_sub_f32 %1, %1, %16\n\tv_sub_f32 %2, %2, %16\n\tv_sub_f32 %3, %3, %16\n\tv_sub_f32 %4, %4, %16\n\tv_sub_f32 %5, %5, %16\n\tv_sub_f32 %6, %6, %16\n\tv_sub_f32 %7, %7, %16\n\t" \
        "v_sub_f32 %8, %8, %16\n\tv_sub_f32 %9, %9, %16\n\tv_sub_f32 %10, %10, %16\n\tv_sub_f32 %11, %11, %16\n\tv_sub_f32 %12, %12, %16\n\tv_sub_f32 %13, %13, %16\n\tv_sub_f32 %14, %14, %16\n\tv_sub_f32 %15, %15, %16" \
        : "+v"(P[0]), "+v"(P[1]), "+v"(P[2]), "+v"(P[3]), "+v"(P[4]), "+v"(P[5]), "+v"(P[6]), "+v"(P[7]), "+v"(P[8]), "+v"(P[9]), "+v"(P[10]), "+v"(P[11]), "+v"(P[12]), "+v"(P[13]), "+v"(P[14]), "+v"(P[15]) : "v"(D))
#define DA_AMX(M, A_, B_) asm volatile("v_max3_f32 %0, %0, %1, %2" : "+v"(M) : "v"(A_), "v"(B_))
#define DA_MX4(M, P, B) do { M = fmaxf(fmaxf(M, P[B]), P[B + 1]); M = fmaxf(fmaxf(M, P[B + 2]), P[B + 3]); } while (0)
#define DA_PA(X0, X1, Y0, Y1, ks, vs) do { \
        const int ka_ = kb0 + (ks) * DA_KS, vb_ = vb0 + (vs) * DA_VS; \
        DA_KFR(0, ka_); DA_KFR(1, ka_); \
        pk[0] = DA_C4(Y0, 0, pk[0]); pk[1] = DA_C4(Y0, 4, pk[1]); \
        DA_LGKM(2); SBAR(); \
        X0 = DA_QKM(0); DA_VFR(0, 0, vb_); pk[2] = DA_C4(Y0, 8, pk[2]); pk[3] = DA_C4(Y0, 12, pk[3]); SBAR(); \
        DA_LGKM(2); SBAR(); \
        X1 = DA_QKM(1); pk[4] = DA_C4(Y1, 0, pk[4]); pk[5] = DA_C4(Y1, 4, pk[5]); pk[6] = DA_C4(Y1, 8, pk[6]); pk[7] = DA_C4(Y1, 12, pk[7]); DA_PIN(pk); DA_VFR(1, 1, vb_); SBAR();     \
        ol = __builtin_amdgcn_mfma_scale_f32_32x32x64_f8f6f4(pk, ones8, ol, 0, 0, 0, 0, 0, 0); SBAR(); } while (0)
#define DA_PB(X0, X1, vs) do { float ALX; bool RS_; const int vb_ = vb0 + (vs) * DA_VS; \
        DA_LGKM(2); SBAR(); DA_PVM(0, 0); DA_VFR(2, 2, vb_); SBAR(); \
        float mx_;                                                  \
        asm volatile("v_max3_f32 %0, %1, %2, %3\n\tv_max3_f32 %0, %0, %4, %5\n\tv_max3_f32 %0, %0, %6, %7\n\tv_max3_f32 %0, %0, %8, %9\n\tv_max3_f32 %0, %0, %10, %11\n\tv_max3_f32 %0, %0, %12, %13\n\tv_max3_f32 %0, %0, %14, %15\n\tv_max_f32 %0, %0, %16" \
            : "=&v"(mx_) : "v"(X0[0]), "v"(X0[1]), "v"(X0[2]), "v"(X0[3]), "v"(X0[4]), "v"(X0[5]), "v"(X0[6]), "v"(X0[7]), "v"(X0[8]), "v"(X0[9]), "v"(X0[10]), "v"(X0[11]), "v"(X0[12]), "v"(X0[13]), "v"(X0[14]), "v"(X0[15])); \
        { float t_;                                                 \
        asm volatile("v_max3_f32 %0, %0, %2, %3\n\tv_max3_f32 %0, %0, %4, %5\n\tv_max3_f32 %0, %0, %6, %7\n\tv_max3_f32 %0, %0, %8, %9\n\tv_max3_f32 %0, %0, %10, %11\n\tv_max3_f32 %0, %0, %12, %13\n\tv_max3_f32 %0, %0, %14, %15\n\tv_max3_f32 %0, %0, %16, %17\n\t" \
                     "v_mov_b32 %1, %0\n\ts_nop 1\n\tv_permlane32_swap_b32 %0, %1\n\tv_max_f32 %0, %0, %1" \
            : "+v"(mx_), "=&v"(t_) : "v"(X1[0]), "v"(X1[1]), "v"(X1[2]), "v"(X1[3]), "v"(X1[4]), "v"(X1[5]), "v"(X1[6]), "v"(X1[7]), "v"(X1[8]), "v"(X1[9]), "v"(X1[10]), "v"(X1[11]), "v"(X1[12]), "v"(X1[13]), "v"(X1[14]), "v"(X1[15])); } \
            { \
              ALX = 1.f; RS_ = !__all(mx_ <= DA_PLIM); if (RS_) { const float dl = fmaxf(mx_ - DA_POFF, 0.f); ALX = __builtin_amdgcn_exp2f(-dl); m_reg += dl; \
                  _Pragma("unroll") for (int r = 0; r < 16; ++r) { X0[r] -= dl; asm volatile("" : "+v"(X0[r])); X1[r] -= dl; asm volatile("" : "+v"(X1[r])); }     \
                  _Pragma("unroll") for (int r = 0; r < 16; ++r) negm[r] = -m_reg; asm volatile("" : "+v"(negm)); } } SBAR(); \
        DA_LGKM(2); SBAR(); DA_PVM(1, 1); DA_VFR(0, 3, vb_); DA_EX(X0, 0); DA_EX(X0, 1); DA_EX(X0, 2); DA_EX(X0, 3); DA_EX(X0, 4); DA_EX(X0, 5); DA_EX(X0, 6); DA_EX(X0, 7); DA_EX(X0, 8); DA_EX(X0, 9); DA_EX(X0, 10); DA_PIN(X0); SBAR(); \
        DA_LGKM(2); SBAR(); DA_PVM(2, 2); DA_EX(X0, 11); DA_EX(X0, 12); DA_EX(X0, 13); DA_EX(X0, 14); DA_EX(X0, 15); DA_EX(X1, 0); DA_EX(X1, 1); DA_EX(X1, 2); DA_EX(X1, 3); DA_EX(X1, 4); DA_EX(X1, 5); DA_PIN(X0); DA_PIN(X1); SBAR(); \
        DA_LGKM(0); SBAR(); DA_PVM(3, 0); DA_EX(X1, 6); DA_EX(X1, 7); DA_EX(X1, 8); DA_EX(X1, 9); DA_EX(X1, 10); DA_EX(X1, 11); DA_EX(X1, 12); DA_EX(X1, 13); DA_EX(X1, 14); DA_EX(X1, 15); DA_PIN(X1); SBAR(); \
        if (RS_) { if (hi == 0) wsf[r32] = (ALX); asm volatile("s_waitcnt lgkmcnt(0)" ::: "memory"); \
            _Pragma("unroll") for (int r = 0; r < 16; ++r) { const float a_ = wsf[crow(r, hi)]; ol[r] *= a_; _Pragma("unroll") for (int d = 0; d < 4; ++d) o[d][r] *= a_; } } \
    } while (0)
#define DA_NEXT3(x) (((x) == 2) ? 0 : (x) + 1)
#define DA_PREV3(x) (((x) == 0) ? 2 : (x) - 1)
#define DA_A0() do { DA_KFR(0, kb0); DA_KFR(1, kb0); DA_LGKM(0); SBAR(); pA0 = DA_QKM(0); pA1 = DA_QKM(1); SBAR(); } while (0)
#define DA_B0() do { float mx_ = pA0[0]; \
      _Pragma("unroll") for (int r = 1; r < 16; ++r) mx_ = fmaxf(mx_, pA0[r]); \
      _Pragma("unroll") for (int r = 0; r < 16; ++r) mx_ = fmaxf(mx_, pA1[r]); \
      { auto rr = __builtin_amdgcn_permlane32_swap(__float_as_uint(mx_), __float_as_uint(mx_), false, false); mx_ = fmaxf(__uint_as_float(rr[0]), __uint_as_float(rr[1])); } \
      m_reg = mx_ - DA_POFF; \
      _Pragma("unroll") for (int r = 0; r < 16; ++r) { pA0[r] -= m_reg; pA1[r] -= m_reg; negm[r] = -m_reg; } \
      asm volatile("" : "+v"(negm)); \
      _Pragma("unroll") for (int r = 0; r < 16; ++r) { DA_EX(pA0, r); DA_EX(pA1, r); } } while (0)
#define DA_DRAIN() do { \
      pk[0] = DA_C4(pB0, 0, pk[0]); pk[1] = DA_C4(pB0, 4, pk[1]); pk[2] = DA_C4(pB0, 8, pk[2]); pk[3] = DA_C4(pB0, 12, pk[3]); pk[4] = DA_C4(pB1, 0, pk[4]); pk[5] = DA_C4(pB1, 4, pk[5]); pk[6] = DA_C4(pB1, 8, pk[6]); pk[7] = DA_C4(pB1, 12, pk[7]); \
      const int vb_ = vb0 + ((NT - 1) & 3) * DA_VS; \
      ol = __builtin_amdgcn_mfma_scale_f32_32x32x64_f8f6f4(pk, ones8, ol, 0, 0, 0, 0, 0, 0); \
      DA_VFR(0, 0, vb_); DA_VFR(1, 1, vb_); DA_VFR(2, 2, vb_); DA_LGKM(4); SBAR(); DA_PVM(0, 0); SBAR(); DA_LGKM(2); SBAR(); DA_PVM(1, 1); SBAR(); \
      asm volatile("s_nop 7\n\ts_nop 7" ::: "memory"); DA_VFR(0, 3, vb_); DA_LGKM(2); SBAR(); DA_PVM(2, 2); SBAR(); DA_LGKM(0); SBAR(); DA_PVM(3, 0); SBAR(); } while (0)
    static_assert(NT == 260, "the unrolled loops and their tails are written for 260 tiles");
    DA_WB_STEADY();
    if (kw) {
        DA_A0(); DA_B0();
        DA_WAITBAR(3);
        for (int j = 1; j + 6 < NT; j += 4) {
            DA_DMA_K(j + 2, 3); DA_DMA_V(j + 1, 2);
            DA_PA(pB0, pB1, pA0, pA1, 1, 0); DA_PB(pB0, pB1, 0); DA_WAITBAR(3);
            DA_DMA_K(j + 3, 0); DA_DMA_V(j + 2, 3);
            DA_PA(pA0, pA1, pB0, pB1, 2, 1); DA_PB(pA0, pA1, 1); DA_WAITBAR(3);
            DA_DMA_K(j + 4, 1); DA_DMA_V(j + 3, 0);
            DA_PA(pB0, pB1, pA0, pA1, 3, 2); DA_PB(pB0, pB1, 2); DA_WAITBAR(3);
            DA_DMA_K(j + 5, 2); DA_DMA_V(j + 4, 1);
            DA_PA(pA0, pA1, pB0, pB1, 0, 3); DA_PB(pA0, pA1, 3); DA_WAITBAR(3);
        }
        DA_DMA_K(259, 3); DA_DMA_V(258, 2);
        DA_PA(pB0, pB1, pA0, pA1, 1, 0); DA_PB(pB0, pB1, 0); DA_WAITBAR(3);
        DA_DMA_V(259, 3);
        DA_PA(pA0, pA1, pB0, pB1, 2, 1); DA_PB(pA0, pA1, 1); DA_WAITBAR(0);
        DA_PA(pB0, pB1, pA0, pA1, 3, 2); DA_PB(pB0, pB1, 2); DA_WAITBAR(0);
        DA_DRAIN();
    } else {
        DA_A0();
        DA_WAITBAR(0);
        DA_DMA_V(2, 2);
        DA_B0(); DA_PA(pB0, pB1, pA0, pA1, 1, 0); DA_WAITBAR(0);
        for (int j = 2; j + 5 < NT; j += 4) {
            DA_DMA_V(j + 1, 3);
            DA_PB(pB0, pB1, 0); DA_PA(pA0, pA1, pB0, pB1, 2, 1); DA_WAITBAR(0);
            DA_DMA_V(j + 2, 0);
            DA_PB(pA0, pA1, 1); DA_PA(pB0, pB1, pA0, pA1, 3, 2); DA_WAITBAR(0);
            DA_DMA_V(j + 3, 1);
            DA_PB(pB0, pB1, 2); DA_PA(pA0, pA1, pB0, pB1, 0, 3); DA_WAITBAR(0);
            DA_DMA_V(j + 4, 2);
            DA_PB(pA0, pA1, 3); DA_PA(pB0, pB1, pA0, pA1, 1, 0); DA_WAITBAR(0);
        }
        DA_DMA_V(259, 3);
        DA_PB(pB0, pB1, 0); DA_PA(pA0, pA1, pB0, pB1, 2, 1); DA_WAITBAR(0);
        DA_PB(pA0, pA1, 1); DA_PA(pB0, pB1, pA0, pA1, 3, 2); DA_WAITBAR(0);
        DA_PB(pB0, pB1, 2);
        DA_DRAIN();
    }
#pragma unroll
    for (int r = 0; r < 16; ++r) { const float rl = __builtin_amdgcn_rcpf(ol[r]);
#pragma unroll
        for (int d = 0; d < 4; ++d) o[d][r] *= rl; }
    DA_WAITBAR(0);
#undef DA_TROW
#undef DA_DMA_K
#undef DA_DMA_V
#undef DA_WB_STEADY
#undef DA_KRD
#undef DA_KFR
#undef DA_KF8
#undef DA_QKM
#undef DA_VFR
#undef DA_VF8
#undef DA_PVM
#undef DA_C4
#undef DA_ADD4
#undef DA_EX
#undef DA_PIN
#undef DA_MX4
#undef DA_AMX
#undef DA_SUB16
#undef DA_PA
#undef DA_PB
#undef DA_A0
#undef DA_B0
#undef DA_DRAIN
#undef DA_NEXT3
#undef DA_PREV3
}
#undef SBAR
}

typedef GAS unsigned gu32;
#define RLX_AGENT __ATOMIC_RELAXED, __HIP_MEMORY_SCOPE_AGENT
#define XB_TMO      128
#define XB_XCNT(j)  (256  + 64 * (j))
#define XB_XSUB(j)  (1280 + 64 * (j))
#define XB_XGEN(j)  (2304 + 64 * (j))
#define XB_TOP      3328
#define XB_TOPGEN   3392
#define XCD_BAR_WORDS 3456
#define XB_SPIN_CAP (1u << 20)
__device__ __forceinline__ unsigned xb_ld(unsigned* p)              { return __hip_atomic_load(p, __ATOMIC_RELAXED, __HIP_MEMORY_SCOPE_AGENT); }
__device__ __forceinline__ unsigned xb_add(unsigned* p, unsigned v) { return __hip_atomic_fetch_add(p, v, __ATOMIC_RELAXED, __HIP_MEMORY_SCOPE_AGENT); }
__device__ __forceinline__ unsigned xb_xcc_id() { return (unsigned)__builtin_amdgcn_s_getreg((3 << 11) | 20) & 0xFu; }
#define XB_SPIN(cond, bar) do { unsigned _sp = 0; while (cond) { __builtin_amdgcn_s_sleep(1); \
    if ((++_sp & 255u) == 0u) { if (xb_ld(&(bar)[XB_TMO])) break; if (_sp > XB_SPIN_CAP) { atomicAdd(&(bar)[XB_TMO], 1u); break; } } } } while (0)
struct XcdBarrier { unsigned* bar; unsigned x; volatile LAS unsigned* st; };
__device__ __forceinline__ XcdBarrier xcd_barrier_post(unsigned* bar, volatile LAS unsigned* st) {
    XcdBarrier b; b.bar = bar; b.x = xb_xcc_id(); b.st = st;
    if (threadIdx.x == 0) (void)xb_add(&bar[XB_XCNT(b.x)], 1u);
    return b;
}
__device__ __forceinline__ void xcd_barrier_complete(unsigned* bar, unsigned x, unsigned& nloc, unsigned& nx) {
    const unsigned G = gridDim.x * gridDim.y * gridDim.z;
    unsigned sum, cnt, mine, sp = 0u;
    for (;;) {
        sum = 0u; cnt = 0u; mine = 0u;
#pragma unroll
        for (unsigned j = 0; j < 16; ++j) { const unsigned c = xb_ld(&bar[XB_XCNT(j)]); sum += c; cnt += (c > 0u) ? 1u : 0u; mine = (j == x) ? c : mine; }
        if (sum == G) break;
        __builtin_amdgcn_s_sleep(1);
        if ((++sp & 255u) == 0u) { if (xb_ld(&bar[XB_TMO])) break; if (sp > XB_SPIN_CAP) { atomicAdd(&bar[XB_TMO], 1u); break; } }
    }
    nloc = mine > 0u ? mine : 1u; nx = cnt > 0u ? cnt : 1u;
}
__device__ __forceinline__ void xcd_barrier(const XcdBarrier& b) {
    asm volatile("s_waitcnt vmcnt(0)" ::: "memory");
    __syncthreads();
    if (threadIdx.x == 0) {
        unsigned* bar = b.bar;
        __builtin_amdgcn_s_waitcnt(0);
        unsigned nloc = b.st[0], nx = b.st[1];
        if (nloc == 0u) { xcd_barrier_complete(bar, b.x, nloc, nx); b.st[0] = nloc; b.st[1] = nx; }
        const unsigned old = xb_add(&bar[XB_XSUB(b.x)], 1u);
        const unsigned gen = old / nloc;
        if (old + 1u == (gen + 1u) * nloc) {
            __builtin_amdgcn_fence(__ATOMIC_RELEASE, "agent");
            asm volatile("s_waitcnt vmcnt(0)" ::: "memory");
            const unsigned og = xb_add(&bar[XB_TOP], 1u);
            const unsigned tg = og / nx;
            if (og + 1u == (tg + 1u) * nx) xb_add(&bar[XB_TOPGEN], 1u);
            else XB_SPIN(xb_ld(&bar[XB_TOPGEN]) == tg, bar);
            __builtin_amdgcn_fence(__ATOMIC_ACQUIRE, "agent");
            xb_add(&bar[XB_XGEN(b.x)], 1u);
            asm volatile("s_waitcnt vmcnt(0)" ::: "memory");
        } else {
            XB_SPIN(xb_ld(&bar[XB_XGEN(b.x)]) == gen, bar);
            __builtin_amdgcn_fence(__ATOMIC_ACQUIRE, "agent");
            asm volatile("s_waitcnt vmcnt(0)" ::: "memory");
        }
    }
    __syncthreads();
}

constexpr int NWAVES = 8;
struct Args { const float* in[26]; float* out; unsigned char* ws; int ph_lo, ph_hi; };
static_assert(sizeof(Args) == 26 * 8 + 8 + 8 + 8, "Args has no padding");

struct Frame {
    LAS unsigned char* lds;
    int tid, lane, wave, vcu, G;
};
typedef const __attribute__((address_space(4))) Args* KArgs;
__device__ __forceinline__ KArgs get_args() { KArgs p = (KArgs)__builtin_amdgcn_kernarg_segment_ptr(); asm volatile("" : "+s"(p)); return p; }
enum In { I_X = 0, I_C, I_CTX, I_CCTX, I_WMOD, I_BMOD, I_NMPRE, I_NMPOST, I_NFPRE, I_NFPOST, I_NAQKV, I_NAWO, I_NARPB, I_DQKV, I_DWO, I_LQ1, I_LK1, I_LQ2, I_LK2, I_SUBLN,
          I_WR, I_BR, I_WGU, I_BGU, I_WDN, I_BDN };

__device__ __forceinline__ void p0_transpose_item(const float* W, int K, int N, bf16_t* WT, int drow0, int k0, int n0, LAS float* scr, int lane) {
#pragma unroll 8
    for (int i = 0; i < 32; ++i) { const int kk = 2 * i + (lane >> 5); scr[kk * 33 + (lane & 31)] = W[(size_t)(k0 + kk) * N + n0 + (lane & 31)]; }
    LDS_WAIT(); asm volatile("" ::: "memory");
    const int c = lane & 7;
#pragma unroll
    for (int j = 0; j < 4; ++j) { const int n = (lane >> 3) + 8 * j; const LAS float* s = scr + (8 * c) * 33 + n;
        u32x4 o; o.x = cvt_pk_bf16(s[0 * 33], s[1 * 33]); o.y = cvt_pk_bf16(s[2 * 33], s[3 * 33]); o.z = cvt_pk_bf16(s[4 * 33], s[5 * 33]); o.w = cvt_pk_bf16(s[6 * 33], s[7 * 33]);
        *(GAS u32x4*)(WT + (size_t)(drow0 + n) * K + k0 + 8 * c) = o; }
    LDS_WAIT(); asm volatile("" ::: "memory");
}

__device__ __forceinline__ void p0_transpose_item_f8(const float* W, int K, int N, unsigned char* WT, int drow0, int k0, int n0, LAS float* scr, int lane) {
#pragma unroll 8
    for (int i = 0; i < 32; ++i) { const int kk = 2 * i + (lane >> 5); scr[kk * 33 + (lane & 31)] = W[(size_t)(k0 + kk) * N + n0 + (lane & 31)] * 32.f; }
    LDS_WAIT(); asm volatile("" ::: "memory");
    const int c = lane & 7;
#pragma unroll
    for (int j = 0; j < 4; ++j) { const int n = (lane >> 3) + 8 * j; const LAS float* s = scr + (8 * c) * 33 + n;
        int w0 = __builtin_amdgcn_cvt_pk_fp8_f32(s[0 * 33], s[1 * 33], 0, false); w0 = __builtin_amdgcn_cvt_pk_fp8_f32(s[2 * 33], s[3 * 33], w0, true);
        int w1 = __builtin_amdgcn_cvt_pk_fp8_f32(s[4 * 33], s[5 * 33], 0, false); w1 = __builtin_amdgcn_cvt_pk_fp8_f32(s[6 * 33], s[7 * 33], w1, true);
        *(GAS u32x2*)(WT + (size_t)(drow0 + n) * K + k0 + 8 * c) = (u32x2){(unsigned)w0, (unsigned)w1}; }
    LDS_WAIT(); asm volatile("" ::: "memory");
}
__device__ __forceinline__ void p0_item64_f8(const float* W, int K, int N, unsigned char* WT, int drow0, int k0, int n0, LAS float* scr, int lane) {
#pragma unroll 8
    for (int i = 0; i < 64; ++i) scr[i * 65 + lane] = W[(size_t)(k0 + i) * N + n0 + lane] * 32.f;
    LDS_WAIT(); asm volatile("" ::: "memory");
    const int c = lane & 7;
#pragma unroll
    for (int j = 0; j < 8; ++j) { const int n = (lane >> 3) + 8 * j; const LAS float* s = scr + (8 * c) * 65 + n;
        int w0 = __builtin_amdgcn_cvt_pk_fp8_f32(s[0 * 65], s[1 * 65], 0, false); w0 = __builtin_amdgcn_cvt_pk_fp8_f32(s[2 * 65], s[3 * 65], w0, true);
        int w1 = __builtin_amdgcn_cvt_pk_fp8_f32(s[4 * 65], s[5 * 65], 0, false); w1 = __builtin_amdgcn_cvt_pk_fp8_f32(s[6 * 65], s[7 * 65], w1, true);
        *(GAS u32x2*)(WT + (size_t)(drow0 + n) * K + k0 + 8 * c) = (u32x2){(unsigned)w0, (unsigned)w1}; }
    LDS_WAIT(); asm volatile("" ::: "memory");
}
__device__ __forceinline__ void ld_row_f32(f32x4 (&v)[4], const float* p, int lane) {
#pragma unroll
    for (int j = 0; j < 4; ++j) v[j] = *(const f32x4*)(p + 4 * lane + 256 * j);
}
__device__ __forceinline__ void st_row_f32(float* p, const f32x4 (&v)[4], int lane) {
#pragma unroll
    for (int j = 0; j < 4; ++j) *(f32x4*)(p + 4 * lane + 256 * j) = v[j];
}
__device__ __forceinline__ void ld_row_bf16(f32x4 (&v)[4], const bf16_t* p, int lane) {
#pragma unroll
    for (int j = 0; j < 4; ++j) { const u32x2 w = *(const u32x2*)(p + 4 * lane + 256 * j); v[j] = (f32x4){bflo(w.x), bfhi(w.x), bflo(w.y), bfhi(w.y)}; }
}
__device__ __forceinline__ void st_row_bf16(bf16_t* p, const f32x4 (&v)[4], int lane) {
#pragma unroll
    for (int j = 0; j < 4; ++j) { u32x2 w; w.x = cvt_pk_bf16(v[j][0], v[j][1]); w.y = cvt_pk_bf16(v[j][2], v[j][3]); *(u32x2*)(p + 4 * lane + 256 * j) = w; }
}
__device__ __forceinline__ void st_row_fp8(unsigned char* p, const f32x4 (&v)[4], int lane) {
#pragma unroll
    for (int j = 0; j < 4; ++j) { int w = __builtin_amdgcn_cvt_pk_fp8_f32(v[j][0], v[j][1], 0, false); w = __builtin_amdgcn_cvt_pk_fp8_f32(v[j][2], v[j][3], w, true); *(int*)(p + 4 * lane + 256 * j) = w; }
}
__device__ __forceinline__ float row_sumsq(const f32x4 (&v)[4]) {
    float s = 0.f;
#pragma unroll
    for (int j = 0; j < 4; ++j) s += (v[j][0] * v[j][0] + v[j][1] * v[j][1]) + (v[j][2] * v[j][2] + v[j][3] * v[j][3]);
    return wave_sum(s);
}
__device__ __forceinline__ void norm_mod(f32x4 (&h)[4], const f32x4 (&x)[4], const float* w, const float* sc, const float* sh, int lane) {
    const float rs = 1.0f / sqrtf(row_sumsq(x) * (1.f / DM) + NORM_EPS);
#pragma unroll
    for (int j = 0; j < 4; ++j) { const int c = 4 * lane + 256 * j; const f32x4 wv = *(const f32x4*)(w + c), sv = *(const f32x4*)(sc + c), hv = *(const f32x4*)(sh + c);
        h[j] = (x[j] * rs) * wv * (sv + 1.f) + hv; }
}
__device__ __forceinline__ const float* src_row(KArgs a, int row) {
    return row < NLAT ? a->in[I_X] + (size_t)row * DM : a->in[I_CTX] + (size_t)(row - NLAT) * DM;
}

#define MOD ((float*)(ws + WS_MOD))
#define WRT ((float*)(ws + WS_WRT))
#define ROPE ((float*)(ws + WS_ROPE))
#define WQKV ((bf16_t*)(ws + WS_WQKV))
#define WO ((bf16_t*)(ws + WS_WO))
#define WGU8 ((unsigned char*)(ws + WS_WGU))
#define WDN8 ((unsigned char*)(ws + WS_WDN))
#define XS ((bf16_t*)(ws + WS_XS))
#define XN ((bf16_t*)(ws + WS_XN))
#define XNQ8 ((unsigned char*)(ws + WS_XN))
#define OB8 ((unsigned char*)(ws + WS_O))
#define WQKV8 ((unsigned char*)(ws + WS_WQKV))
#define WO8 ((unsigned char*)(ws + WS_WO))
#define QB ((bf16_t*)(ws + WS_Q))
#define KB ((bf16_t*)(ws + WS_K))
#define VB ((bf16_t*)(ws + WS_V))
#define OB ((bf16_t*)(ws + WS_O))
#define TB ((bf16_t*)(ws + WS_T))
#define ACT ((bf16_t*)(ws + WS_ACT))
#define ACT8 ((unsigned char*)(ws + WS_ACT))
#define XN8 ((unsigned char*)(ws + WS_XN8))
#define YB ((bf16_t*)(ws + WS_Y))
#define TOKOF ((int*)(ws + WS_TOKOF))
#define SLOT ((int*)(ws + WS_SLOT))
#define GATE ((float*)(ws + WS_GATE))
#define CTLW ((unsigned*)(ws + WS_CTL))
#if MK_SPLIT
#define GRID_BAR() do { } while (0)
#else
#define GRID_BAR() xcd_barrier(bar)
#endif
#define IN_PH() (lo <= ph && ph < hi)
#define END_PH() do { if (IN_PH() && ph + 1 < hi) GRID_BAR(); ++ph; } while (0)
__device__ __forceinline__ int opaque(int v) { asm volatile("" : "+v"(v)); return v; }
#define PH_BEGIN() KArgs A = get_args(); unsigned char* const ws = A->ws; (void)ws; const int lane = opaque((int)__builtin_amdgcn_mbcnt_hi(~0u, __builtin_amdgcn_mbcnt_lo(~0u, 0u))); (void)lane
constexpr int NQL = 32 * 512 + 32 * 256;
struct ConvBG {
    static constexpr int NH = 2 * 2 * NQL;
    KArgs A; unsigned char* ws; LAS float* scr; int lane, hq, hstride; bool pending; f32x4 v[8]; unsigned char* dst; int dK;
    __device__ __forceinline__ void step() {
        if (pending) {
            const int li = lane >> 4, lq = lane & 15;
#pragma unroll
            for (int r = 0; r < 8; ++r) { LAS float* d = scr + (4 * r + li) * 65 + 4 * lq; d[0] = v[r][0] * 32.f; d[1] = v[r][1] * 32.f; d[2] = v[r][2] * 32.f; d[3] = v[r][3] * 32.f; }
            LDS_WAIT(); asm volatile("" ::: "memory");
            const int c = lane & 3;
#pragma unroll
            for (int j = 0; j < 4; ++j) { const int n = (lane >> 2) + 16 * j; const LAS float* sp = scr + (8 * c) * 65 + n;
                int w0 = __builtin_amdgcn_cvt_pk_fp8_f32(sp[0 * 65], sp[1 * 65], 0, false); w0 = __builtin_amdgcn_cvt_pk_fp8_f32(sp[2 * 65], sp[3 * 65], w0, true);
                int w1 = __builtin_amdgcn_cvt_pk_fp8_f32(sp[4 * 65], sp[5 * 65], 0, false); w1 = __builtin_amdgcn_cvt_pk_fp8_f32(sp[6 * 65], sp[7 * 65], w1, true);
                *(GAS u32x2*)(dst + (size_t)n * dK + 8 * c) = (u32x2){(unsigned)w0, (unsigned)w1}; }
            LDS_WAIT(); asm volatile("" ::: "memory");
        }
        if (hq < NH) {
            const int q = hq >> 1, half = hq & 1, layer = q / NQL; int r = q - layer * NQL; const float* src; int N;
            if (r < 16384) { const int le = layer * 32 + (r >> 9); r &= 511; const int kb = r >> 5, nb = r & 31, n0 = 64 * nb, k0 = 64 * kb + 32 * half;
                const int drow = (n0 < FF) ? (n0 >> 7) * 256 + (n0 & 127) : ((n0 - FF) >> 7) * 256 + 128 + ((n0 - FF) & 127);
                N = 2 * FF; src = A->in[I_WGU] + (size_t)le * DM * 2 * FF + (size_t)k0 * N + n0; dst = WGU8 + (size_t)le * 2 * FF * DM + (size_t)drow * DM + k0; dK = DM; }
            else { r -= 16384; const int le = layer * 32 + (r >> 8); r &= 255; const int kb = r >> 4, nb = r & 15, k0 = 64 * kb + 32 * half;
                N = DM; src = A->in[I_WDN] + (size_t)le * FF * DM + (size_t)k0 * N + 64 * nb; dst = WDN8 + (size_t)le * DM * FF + (size_t)(64 * nb) * FF + k0; dK = FF; }
            const float* p = src + (size_t)(lane >> 4) * N + 4 * (lane & 15);
#pragma unroll
            for (int r8 = 0; r8 < 8; ++r8) v[r8] = *(const f32x4*)(p + (size_t)(4 * r8) * N);
            pending = true; hq += hstride;
        } else pending = false;
    }
};
template <int l>
__device__ __forceinline__ void run_layer(const Frame& F, unsigned char* lds, const int lo, const int hi, int& ph
#if !MK_SPLIT
    , const XcdBarrier& bar
#endif
    ) {
    const int lane = opaque(F.lane);
    const int gw = F.vcu * NWAVES + F.wave, NGW = F.G * NWAVES;
    LAS int* T_cnt = (LAS int*)(F.lds + TAB_OFF);
    LAS int* T_ts = (LAS int*)(F.lds + TAB_OFF + 128);
    LAS int* T_te = (LAS int*)(F.lds + TAB_OFF + 512);
    LAS int* T_hist = (LAS int*)(F.lds + TAB_OFF + 4096);
    LAS int* T_base = (LAS int*)(F.lds + TAB_OFF + 4096 + 128);
    LAS int* T_info = (LAS int*)(F.lds + TAB_OFF + 4608);
        if (IN_PH()) { PH_BEGIN();
            pg8::DenseOrder S; S.init(NTOK / 256, 12, F.G, (int)blockIdx.x);
            pg8::EpiQKV E{QB, (size_t)(WS_K - WS_Q) / 2, QSCALE, l == 1 ? ROPE : nullptr, ((DENSE_FP8 >> l) & 1) ? 0.03125f : 1.f};
            for (int rep = 0; rep < REP_DENSE; ++rep)
            if constexpr (((DENSE_FP8 >> l) & 1) != 0) pg8::gemm_phase<1>(F.lds, XNQ8, WQKV8 + (size_t)l * 6 * DM * DM, DM, 0, S, E, pg8::RowDense{});
            else pg8::gemm_phase<2>(F.lds, XN, WQKV + (size_t)l * 3 * DM * DM, DM, 0, S, E, pg8::RowDense{});
        }
        END_PH();
        if constexpr (l == 1) {
            if (IN_PH()) { PH_BEGIN();
                LAS unsigned short* vt_l = (LAS unsigned short*)F.lds;
                unsigned char* VT8 = (unsigned char*)ACT;
                u32x4 a0 = (u32x4){0u, 0u, 0u, 0u}, a1 = a0;
#define VT_LOAD(TT) do { const int t_ = (TT) % 260, bh_ = (TT) / 260, h_ = bh_ & 7, b_ = bh_ >> 3; \
                    const int trow_ = t_ < 256 ? b_ * SEQ + t_ * 64 : NLAT + b_ * CTXL + (t_ - 256) * 64; \
                    const bf16_t* srcp = VB + (size_t)(trow_ + (F.tid >> 3)) * DM + h_ * 128 + (F.tid & 7) * 16; a0 = *(const u32x4*)srcp; a1 = *(const u32x4*)(srcp + 8); } while (0)
                if (F.vcu < BATCH * 8 * 260) VT_LOAD(F.vcu);
                for (int T = F.vcu; T < BATCH * 8 * 260; T += F.G) {
                    { const int k = F.tid >> 3, c16 = (F.tid & 7) * 16;
                      *(LAS u32x4*)(vt_l + k * 136 + c16) = a0; *(LAS u32x4*)(vt_l + k * 136 + c16 + 8) = a1; }
                    __syncthreads();
                    if (T + F.G < BATCH * 8 * 260) VT_LOAD(T + F.G);
                    { const int c = F.tid & 127, ch = F.tid >> 7, hh = ch >> 1, half = ch & 1; float f[16];
#pragma unroll
                      for (int e = 0; e < 16; ++e) { const int key = half * 32 + att::crow(e, hh); f[e] = __uint_as_float((unsigned)vt_l[key * 136 + c] << 16); }
                      u32x4 w;
#pragma unroll
                      for (int q = 0; q < 4; ++q) { int t_ = __builtin_amdgcn_cvt_pk_fp8_f32(f[4 * q], f[4 * q + 1], 0, false); t_ = __builtin_amdgcn_cvt_pk_fp8_f32(f[4 * q + 2], f[4 * q + 3], t_, true); w[q] = (unsigned)t_; }
                      *(u32x4*)(VT8 + (size_t)T * 8192 + c * 64 + ((ch ^ ((c >> 2) & 3)) * 16)) = w; }
                    __syncthreads();
                }
#undef VT_LOAD
            }
            END_PH();
        }
        if (IN_PH()) { PH_BEGIN();
            if constexpr (l == 0) {
                using L = att::Lay<64>;
                LAS float* bias_l = (LAS float*)(F.lds + L::OFF_BIAS);
                ConvBG bg; bg.A = A; bg.ws = ws; bg.scr = (LAS float*)(F.lds + L::END + F.wave * 8320); bg.lane = lane; bg.hq = gw; bg.hstride = NGW; bg.pending = false; bg.dst = nullptr; bg.dK = 0;
                static_assert(L::END + NWAVES * 8320 <= TAB_OFF, "background scratch");
                for (int rep = 0; rep < REP_NA; ++rep)
                for (int u = F.vcu; u < 2048 + 32; u += F.G) {
                    f32x16 o[2]; int qrow0, hh;
                    if (u < 2048) {
                        const int rg = u & 63, h = (u >> 6) & 15, b = u >> 10; hh = h;
                        for (int i = opaque(F.tid); i < 15 * 32; i += NWAVES * 64) { const int dr_ = i >> 5, dc_ = i & 31; bias_l[i] = dc_ < 31 ? A->in[I_NARPB][h * 465 + dr_ * 31 + dc_] * LOG2E : -INFINITY; }
                        const int R = 4 * rg + (F.wave >> 1), r0R = min(max(R - 4, 0), 248), rmin = min(max(4 * rg - 4, 0), 248), rmax = min(max(4 * rg + 3 - 4, 0), 248) + 7;
                        qrow0 = b * SEQ + 256 * rg + 32 * F.wave;
                        att::attn_run<64, true>(o, QB + (size_t)qrow0 * DM + h * 64, KB + h * 64, VB + h * 64, b * SEQ + rmin * 64, rmax - rmin + 1, NLAT + b * CTXL, 4,
                                                (char*)lds, r0R - rmin, rmin - R + 7, 32 * (F.wave & 1) + (lane & 31), bg);
                    } else {
                        const int v = u - 2048, h = v & 15, b = v >> 4; hh = h;
                        qrow0 = NLAT + b * CTXL + 32 * F.wave;
                        att::attn_run<64, false>(o, QB + (size_t)qrow0 * DM + h * 64, KB + h * 64, VB + h * 64, 0, 0, NLAT + b * CTXL, 4, (char*)lds, 0, 0, 0, bg);
                    }
                    const int r32 = lane & 31, hi2 = lane >> 5;
#pragma unroll
                    for (int r = 0; r < 16; ++r) {
#if (DENSE_FP8 & 4)
                        unsigned char* op = OB8 + (size_t)(qrow0 + att::crow(r, hi2)) * DM + hh * 64 + r32;
#pragma unroll
                        for (int d = 0; d < 2; ++d) op[32 * d] = (unsigned char)(__builtin_amdgcn_cvt_pk_fp8_f32(o[d][r] * 8.f, 0.f, 0, false) & 0xff);
#else
                        bf16_t* op = OB + (size_t)(qrow0 + att::crow(r, hi2)) * DM + hh * 64 + r32;
#pragma unroll
                        for (int d = 0; d < 2; ++d) op[32 * d] = (bf16_t)(cvt_pk_bf16(o[d][r], 0.f) & 0xffffu);
#endif
                    }
                }
                while (bg.pending || bg.hq < ConvBG::NH) bg.step();
            } else {
                LAS unsigned* stash = (LAS unsigned*)(F.lds + att::DA_END);
                float lam;
                { const float a = A->in[I_LQ1][lane] * A->in[I_LK1][lane], b2 = A->in[I_LQ2][lane] * A->in[I_LK2][lane];
                  lam = __expf(wave_sum(a)) - __expf(wave_sum(b2)) + LAMBDA_INIT; }
                const bool xmap = (F.G % 8 == 0) && (F.G >= 8);
                const int nper = xmap ? F.G / 8 : F.G, ustart = xmap ? F.vcu % nper : F.vcu, uend = xmap ? 128 : 1024;
                for (int rep = 0; rep < REP_DIFF; ++rep)
                for (int u = ustart; u < uend; u += nper) {
                    const int h = xmap ? F.vcu / nper : (u & 7), qb = xmap ? (u & 63) : ((u >> 3) & 63), b = xmap ? (u >> 6) : (u >> 9);
                    const int qrow0 = b * SEQ + 256 * qb + 32 * F.wave;
                    f32x16 o[4];
                    att::dattn_run<0>(o, (const unsigned char*)QB + (size_t)qrow0 * DM + (2 * h) * 64, (const unsigned char*)KB + (2 * h) * 64, (const unsigned char*)ACT + (size_t)((b * 8 + h) * 260) * 8192, b * SEQ, NLAT + b * CTXL, (char*)lds);
{ LAS unsigned* st1 = (LAS unsigned*)(uintptr_t)(unsigned)opaque((int)(uintptr_t)(stash + F.tid));
#pragma unroll
                    for (int d = 0; d < 4; ++d)
#pragma unroll
                        for (int r = 0; r < 16; r += 2) st1[(d * 8 + (r >> 1)) * 512] = cvt_pk_bf16(o[d][r], o[d][r + 1]); }
                    f32x16 o2[4];
                    att::dattn_run<0>(o2, (const unsigned char*)QB + (size_t)qrow0 * DM + (2 * h + 1) * 64, (const unsigned char*)KB + (2 * h + 1) * 64, (const unsigned char*)ACT + (size_t)((b * 8 + h) * 260) * 8192, b * SEQ, NLAT + b * CTXL, (char*)lds);
                    float ss[16];
#pragma unroll
                    for (int r = 0; r < 16; ++r) ss[r] = 0.f;
LAS unsigned* st2 = (LAS unsigned*)(uintptr_t)(unsigned)opaque((int)(uintptr_t)(stash + F.tid));
#pragma unroll
                    for (int d = 0; d < 4; ++d)
#pragma unroll
                        for (int r = 0; r < 16; r += 2) { const unsigned w = st2[(d * 8 + (r >> 1)) * 512];
                            o2[d][r] = bflo(w) - lam * o2[d][r]; o2[d][r + 1] = bfhi(w) - lam * o2[d][r + 1];
                            ss[r] += o2[d][r] * o2[d][r]; ss[r + 1] += o2[d][r + 1] * o2[d][r + 1]; }
#pragma unroll
                    for (int r = 0; r < 16; ++r) { float s_ = ss[r];
                        s_ += DPPF(s_, 0xB1, 0xF, 0.f); s_ += DPPF(s_, 0x4E, 0xF, 0.f); s_ += DPPF(s_, 0x141, 0xF, 0.f); s_ += DPPF(s_, 0x140, 0xF, 0.f);
                        { auto rr = __builtin_amdgcn_permlane16_swap(__float_as_uint(s_), __float_as_uint(s_), false, false); s_ = __uint_as_float(rr[0]) + __uint_as_float(rr[1]); }
                        ss[r] = s_; }
                    const int ln = opaque(lane);
                    const int r32 = ln & 31, hi2 = ln >> 5;
                    float sub[4];
#pragma unroll
                    for (int d = 0; d < 4; ++d) sub[d] = A->in[I_SUBLN][32 * d + r32] * (1.f - LAMBDA_INIT);
#pragma unroll
                    for (int r = 0; r < 16; ++r) { const float rs = 1.0f / sqrtf(ss[r] * (1.f / 128.f) + DIFF_EPS);
#if (DENSE_FP8 & 8)
                        unsigned char* op = OB8 + (size_t)(qrow0 + att::crow(r, hi2)) * DM + h * 128 + r32;
#pragma unroll
                        for (int d = 0; d < 4; ++d) op[32 * d] = (unsigned char)(__builtin_amdgcn_cvt_pk_fp8_f32(o2[d][r] * rs * sub[d], 0.f, 0, false) & 0xff); }
#else
                        bf16_t* op = OB + (size_t)(qrow0 + att::crow(r, hi2)) * DM + h * 128 + r32;
#pragma unroll
                        for (int d = 0; d < 4; ++d) op[32 * d] = (bf16_t)(cvt_pk_bf16(o2[d][r] * rs * sub[d], 0.f) & 0xffffu); }
#endif
                }
#if REP_ABL
                for (int rep = 0; rep < REP_ABL; ++rep)
                for (int u = ustart; u < uend; u += nper) {
                    const int h = xmap ? F.vcu / nper : (u & 7), qb = xmap ? (u & 63) : ((u >> 3) & 63), b = xmap ? (u >> 6) : (u >> 9);
                    const int qrow0 = b * SEQ + 256 * qb + 32 * F.wave;
                    f32x16 o[4];
                    att::dattn_run<ABLV>(o, (const unsigned char*)QB + (size_t)qrow0 * DM + (2 * h) * 64, (const unsigned char*)KB + (2 * h) * 64, (const unsigned char*)ACT + (size_t)((b * 8 + h) * 260) * 8192, b * SEQ, NLAT + b * CTXL, (char*)lds);
                    const int r32 = lane & 31, hi2 = lane >> 5;
#pragma unroll
                    for (int r = 0; r < 16; ++r) { bf16_t* op = YB + (size_t)(qrow0 + att::crow(r, hi2)) * DM + h * 128 + r32;
#pragma unroll
                        for (int d = 0; d < 4; ++d) op[32 * d] = (bf16_t)(cvt_pk_bf16(o[d][r], 0.f) & 0xffffu); }
                }
#endif
            }
        }
        END_PH();
        if (IN_PH()) { PH_BEGIN();
            pg8::DenseOrder S; S.init((l == 0 ? NTOK : NLAT) / 256, 4, F.G, (int)blockIdx.x);
            if constexpr (((DENSE_FP8 >> (2 + l)) & 1) != 0) { pg8::EpiPlain E{TB, nullptr, l == 0 ? 0.03125f * 0.125f : 0.03125f};
                pg8::gemm_phase<1>(F.lds, OB8, WO8 + (size_t)l * 2 * DM * DM, DM, 0, S, E, pg8::RowDense{}); }
            else { pg8::EpiPlain E{TB, nullptr, 1.f};
                pg8::gemm_phase<2>(F.lds, OB, WO + (size_t)l * DM * DM, DM, 0, S, E, pg8::RowDense{}); }
        }
        END_PH();
        if (IN_PH()) { PH_BEGIN();
            const int nrows = (l == 0) ? NTOK : NLAT, chunk = (nrows + F.G - 1) / F.G, row_lo = min((int)blockIdx.x * chunk, nrows), row_hi = min(row_lo + chunk, nrows);
            LAS float* wr_l = (LAS float*)F.lds;
            for (int i = opaque(F.tid); i < NE * DM / 4; i += NWAVES * 64) ((LAS f32x4*)wr_l)[i] = ((const f32x4*)(WRT + (size_t)l * NE * DM))[i];
            if (F.tid < NE) T_hist[F.tid] = 0;
            __syncthreads();
            const float brl = A->in[I_BR][l * NE + (lane >> 1)];
            for (int row0 = row_lo + 2 * F.wave; row0 < row_hi; row0 += 2 * NWAVES) {
                const bool two = row0 + 1 < row_hi;
                f32x2 hp[4][4];
                u32x2 traw[2][4], xraw[2][4]; f32x4 xf[2][4];
#pragma unroll
                for (int rr = 0; rr < 2; ++rr) { const int row = (rr == 1 && !two) ? row0 : row0 + rr;
#pragma unroll
                    for (int j = 0; j < 4; ++j) { traw[rr][j] = *(const u32x2*)(TB + (size_t)row * DM + 4 * lane + 256 * j);
                        if (l == 0) xf[rr][j] = *(const f32x4*)(src_row(A, row) + 4 * lane + 256 * j); else xraw[rr][j] = *(const u32x2*)(XS + (size_t)row * DM + 4 * lane + 256 * j); } }
#pragma unroll
                for (int rr = 0; rr < 2; ++rr) {
                    const int row = (rr == 1 && !two) ? row0 : row0 + rr;
                    const int mb = row < NLAT ? (row >> 14) : 2; const float* md = MOD + ((size_t)l * 3 + mb) * 6144;
                    f32x4 t[4], x[4], h[4];
#pragma unroll
                    for (int j = 0; j < 4; ++j) { const u32x2 w = traw[rr][j]; t[j] = (f32x4){bflo(w.x), bfhi(w.x), bflo(w.y), bfhi(w.y)};
                        if (l == 0) x[j] = xf[rr][j]; else { const u32x2 q = xraw[rr][j]; x[j] = (f32x4){bflo(q.x), bfhi(q.x), bflo(q.y), bfhi(q.y)}; } }
                    const float rs = 1.0f / sqrtf(row_sumsq(t) * (1.f / DM) + NORM_EPS);
#pragma unroll
                    for (int j = 0; j < 4; ++j) { const int c = 4 * lane + 256 * j; const f32x4 wv = *(const f32x4*)(A->in[I_NMPOST] + l * DM + c), gv = *(const f32x4*)(md + 2 * DM + c);
                        x[j] = x[j] + gv * ((t[j] * rs) * wv); }
                    const bool live = (rr == 0) || two;
                    if (live) st_row_bf16(XS + (size_t)row * DM, x, lane);
                    norm_mod(h, x, A->in[I_NFPRE] + l * DM, md + 4 * DM, md + 3 * DM, lane);
                    if (live) st_row_fp8(XN8 + (size_t)row * DM, h, lane);
#pragma unroll
                    for (int j = 0; j < 4; ++j)
#pragma unroll
                        for (int k = 0; k < 4; ++k) hp[j][k][rr] = h[j][k];
                }
                f32x2 acc[32];
#pragma unroll
                for (int e = 0; e < 32; ++e) { f32x2 s2 = (f32x2){0.f, 0.f};
#pragma unroll
                    for (int j = 0; j < 4; ++j) { const f32x4 w = *(const LAS f32x4*)(wr_l + e * DM + 256 * j + 4 * lane);
#pragma unroll
                        for (int k = 0; k < 4; ++k) s2 = hp[j][k] * (f32x2){w[k], w[k]} + s2; }
                    acc[e] = s2; }
#pragma unroll
                for (int rr = 0; rr < 2; ++rr) {
                if (rr == 1 && !two) break;
                const int row = row0 + rr;
                float v[32];
#pragma unroll
                for (int e = 0; e < 32; ++e) v[e] = acc[e][rr];
#pragma unroll
                for (int i = 0; i < 16; ++i) { auto rr = __builtin_amdgcn_permlane32_swap(__float_as_uint(v[i]), __float_as_uint(v[16 + i]), false, false); v[i] = __uint_as_float(rr[0]) + __uint_as_float(rr[1]); }
#pragma unroll
                for (int i = 0; i < 8; ++i) { auto rr = __builtin_amdgcn_permlane16_swap(__float_as_uint(v[i]), __float_as_uint(v[8 + i]), false, false); v[i] = __uint_as_float(rr[0]) + __uint_as_float(rr[1]); }
#pragma unroll
                for (int i = 0; i < 4; ++i) { const bool up = (lane & 8) != 0; const float send = up ? v[i] : v[4 + i], keep = up ? v[4 + i] : v[i]; v[i] = keep + DPPF(send, 0x128, 0xF, 0.f); }
#pragma unroll
                for (int i = 0; i < 2; ++i) { const bool up = (lane & 4) != 0; const float send = up ? v[i] : v[2 + i], keep = up ? v[2 + i] : v[i];
                    const float r4 = DPPF(send, 0x124, 0xF, 0.f), r12 = DPPF(send, 0x12C, 0xF, 0.f); v[i] = keep + (up ? r4 : r12); }
                { const bool up = (lane & 2) != 0; const float send = up ? v[0] : v[1], keep = up ? v[1] : v[0]; v[0] = keep + DPPF(send, 0x4E, 0xF, 0.f); }
                float val = v[0] + DPPF(v[0], 0xB1, 0xF, 0.f) + brl;
                int te[4]; float tv[4];
#pragma unroll
                for (int k = 0; k < 4; ++k) {
                    const float m = wave_max(val);
                    const unsigned long long bal = __ballot(val == m);
                    const int first = __builtin_ctzll(bal); te[k] = first >> 1; tv[k] = m;
                    if ((lane >> 1) == te[k]) val = -INFINITY;
                }
                const float e1 = __expf(tv[1] - tv[0]), e2 = __expf(tv[2] - tv[0]), e3 = __expf(tv[3] - tv[0]), inv = 1.f / (1.f + e1 + e2 + e3);
                if (lane < 4) {
                    const int e = lane == 0 ? te[0] : lane == 1 ? te[1] : lane == 2 ? te[2] : te[3];
                    const float g = (lane == 0 ? 1.f : lane == 1 ? e1 : lane == 2 ? e2 : e3) * inv;
                    const int rank = __hip_atomic_fetch_add(&T_hist[e], 1, __ATOMIC_RELAXED, __HIP_MEMORY_SCOPE_WORKGROUP);
                    T_info[(row - row_lo) * 4 + lane] = e | (rank << 8);
                    GATE[(size_t)row * 4 + lane] = g;
                }
            }
            }
            __syncthreads();
            { const int t_ = opaque(F.tid); if (t_ < NE) T_base[t_] = (int)__hip_atomic_fetch_add(CTLW + CW_CNT + l * NE + t_, (unsigned)T_hist[t_], RLX_AGENT); }
            __syncthreads();
            for (int i = opaque(F.tid); i < (row_hi - row_lo) * 4; i += NWAVES * 64) { const int inf = T_info[i], e = inf & 255, pos = T_base[e] + (inf >> 8); const int row = row_lo + (i >> 2);
                TOKOF[e * NTOK + pos] = row; SLOT[(size_t)row * 4 + (i & 3)] = e | (pos << 8); }
            __syncthreads();
        }
        END_PH();
        int n_tiles = 0;
        if (lo <= ph + 2 && ph < hi) { PH_BEGIN();
            __syncthreads();
            if (F.tid == 0) { int ts = 0; for (int e = 0; e < NE; ++e) { const int c = (int)__hip_atomic_load(CTLW + CW_CNT + l * NE + e, RLX_AGENT); T_cnt[e] = c; T_ts[e] = ts; ts += (c + 255) >> 8; } T_ts[NE] = ts; }
            __syncthreads();
            n_tiles = T_ts[NE]; if (n_tiles > MAXTILES) n_tiles = MAXTILES;
            for (int i = F.tid; i < n_tiles; i += NWAVES * 64) { int e = 0; while (e < NE - 1 && i >= T_ts[e + 1]) ++e; T_te[i] = e; }
            __syncthreads();
        }
        if (IN_PH()) { PH_BEGIN();
            pg8::MoeOrder S; S.init(n_tiles, 8, F.G, (int)blockIdx.x, T_te);
            pg8::EpiSwiGLU E{ACT8, A->in[I_BGU] + (size_t)l * NE * 2 * FF};
            pg8::RowMoe RM{TOKOF, T_cnt, T_ts};
            for (int rep = 0; rep < REP_MOE; ++rep)
            pg8::gemm_phase<1>(F.lds, XN8, WGU8 + (size_t)l * NE * 2 * FF * DM, DM, (size_t)2 * FF * DM, S, E, RM);
        }
        END_PH();
        if (IN_PH()) { PH_BEGIN();
            pg8::MoeOrder S; S.init(n_tiles, 4, F.G, (int)blockIdx.x, T_te);
            pg8::EpiPlain E{YB, A->in[I_BDN] + (size_t)l * NE * DM, 0.03125f};
            for (int rep = 0; rep < REP_MOE; ++rep)
            pg8::gemm_phase<1>(F.lds, ACT8, WDN8 + (size_t)l * NE * DM * FF, FF, (size_t)DM * FF, S, E, pg8::RowDense{});
        }
        END_PH();
        if (IN_PH()) { PH_BEGIN();
            const int nrows = (l == 0) ? NTOK : NLAT;
            for (int row = gw; row < nrows; row += NGW) {
                const int mb = row < NLAT ? (row >> 14) : 2; const float* md = MOD + ((size_t)l * 3 + mb) * 6144;
                f32x4 y[4];
#pragma unroll
                for (int j = 0; j < 4; ++j) y[j] = (f32x4){0.f, 0.f, 0.f, 0.f};
#pragma unroll
                for (int k = 0; k < 4; ++k) { const int inf = SLOT[(size_t)row * 4 + k], e = inf & 255, pos = inf >> 8; const float g = GATE[(size_t)row * 4 + k];
                    const size_t slot = (size_t)T_ts[e] * 256 + pos; f32x4 t[4]; ld_row_bf16(t, YB + slot * DM, lane);
#pragma unroll
                    for (int j = 0; j < 4; ++j) y[j] = y[j] + t[j] * g; }
                const float rs = 1.0f / sqrtf(row_sumsq(y) * (1.f / DM) + NORM_EPS);
                f32x4 x[4]; ld_row_bf16(x, XS + (size_t)row * DM, lane);
#pragma unroll
                for (int j = 0; j < 4; ++j) { const int c = 4 * lane + 256 * j; const f32x4 wv = *(const f32x4*)(A->in[I_NFPOST] + l * DM + c), gv = *(const f32x4*)(md + 5 * DM + c);
                    x[j] = x[j] + gv * ((y[j] * rs) * wv); }
                if (l == 0) {
                    st_row_bf16(XS + (size_t)row * DM, x, lane);
                    const float* md1 = MOD + (size_t)(3 + mb) * 6144; f32x4 h[4];
                    norm_mod(h, x, A->in[I_NMPRE] + DM, md1 + DM, md1, lane);
                    if (DENSE_FP8 & 2) st_row_fp8(XNQ8 + (size_t)row * DM, h, lane); else st_row_bf16(XN + (size_t)row * DM, h, lane);
                } else {
                    st_row_f32(A->out + (size_t)row * DM, x, lane);
                }
            }
        }
        END_PH();
}

__global__ void __launch_bounds__(NWAVES * 64, 2) mk_fwd(Args args) {
    extern __shared__ __attribute__((aligned(16))) unsigned char lds[];
    Frame F;
    F.lds = (LAS unsigned char*)lds;
    F.tid = threadIdx.x; F.lane = F.tid & 63; F.wave = __builtin_amdgcn_readfirstlane(F.tid >> 6);
    F.G = gridDim.x; { const int bx = blockIdx.x; F.vcu = (F.G % 8 == 0) ? (bx % 8) * (F.G / 8) + bx / 8 : bx; }
    volatile LAS unsigned* MISC = (volatile LAS unsigned*)(F.lds + MISC_OFF);
    for (int u = opaque(F.tid); u < (LDS_BYTES - MISC_OFF) / 4; u += NWAVES * 64) ((LAS unsigned*)(F.lds + MISC_OFF))[u] = 0u;
    __syncthreads();
#if !MK_SPLIT
    XcdBarrier bar = xcd_barrier_post((unsigned*)(get_args()->ws + WS_CTL) + CW_BAR, MISC + 8);
#endif
    int lo, hi; { KArgs A0 = get_args(); lo = A0->ph_lo; hi = A0->ph_hi; }
    int ph = 0;
    const int gw = F.vcu * NWAVES + F.wave, NGW = F.G * NWAVES;
    const int lane = F.lane;
    LAS int* T_cnt = (LAS int*)(F.lds + TAB_OFF);
    LAS int* T_ts = (LAS int*)(F.lds + TAB_OFF + 128);
    LAS int* T_te = (LAS int*)(F.lds + TAB_OFF + 512);
    LAS int* T_hist = (LAS int*)(F.lds + TAB_OFF + 4096);
    LAS int* T_base = (LAS int*)(F.lds + TAB_OFF + 4096 + 128);
    LAS int* T_info = (LAS int*)(F.lds + TAB_OFF + 4608);

    if (IN_PH()) for (int rep = 0; rep < REP_PRO; ++rep) { PH_BEGIN();
        if ((int)blockIdx.x < 192) {
            LAS float* sl = (LAS float*)F.lds;
            for (int i = F.tid; i < 3 * DM; i += NWAVES * 64) { const int m = i >> 10, k = i & 1023; const float c = (m < 2) ? A->in[I_C][m * DM + k] : A->in[I_CCTX][k]; sl[i] = c / (1.f + __expf(-c)); }
            __syncthreads();
            const int l = blockIdx.x / 96, cg = blockIdx.x % 96, col = cg * 64 + lane;
            const float* wm = A->in[I_WMOD] + (size_t)l * DM * 6144 + col;
            float a0 = 0.f, a1 = 0.f, a2 = 0.f;
            for (int k = F.wave * 128; k < F.wave * 128 + 128; ++k) { const float w = wm[(size_t)k * 6144]; a0 += sl[k] * w; a1 += sl[DM + k] * w; a2 += sl[2 * DM + k] * w; }
            LAS float* red = sl + 3 * DM;
            red[(F.wave * 3 + 0) * 64 + lane] = a0; red[(F.wave * 3 + 1) * 64 + lane] = a1; red[(F.wave * 3 + 2) * 64 + lane] = a2;
            __syncthreads();
            if (F.wave < 3) { float s = A->in[I_BMOD][l * 6144 + col];
#pragma unroll
                for (int w = 0; w < 8; ++w) s += red[(w * 3 + F.wave) * 64 + lane];
                MOD[((size_t)l * 3 + F.wave) * 6144 + col] = s; }
            __syncthreads();
        }
        for (int i = blockIdx.x * (NWAVES * 64) + F.tid; i < SEQ * 32; i += F.G * NWAVES * 64) {
            const int t = i >> 5, j = i & 31; const float pos = (float)(j < 16 ? (t >> 6) : (t & 63));
            const float inv = exp2f(-(float)(j & 15) * (13.287712379549449f / 16.f));
            const float ang = pos * inv; float sn, cs; sn = sinf(ang); cs = cosf(ang);
            *(f32x2*)(ROPE + (size_t)i * 2) = (f32x2){cs, sn};
        }
        for (int i = blockIdx.x * (NWAVES * 64) + F.tid; i < 2 * NE * DM; i += F.G * NWAVES * 64) { const int l = i >> 15, e = (i >> 10) & 31, k = i & 1023; WRT[i] = A->in[I_WR][((size_t)l * DM + k) * NE + e]; }
        {
            LAS float* scr = (LAS float*)(F.lds + F.wave * 16640);
            constexpr int I_QKV = 16 * 48, I_WOI = 16 * 16, I_GU = 16 * 32, I_DN = 16 * 16;
            constexpr int NITEMS = 2 * I_QKV + 2 * I_WOI;
            for (int it = gw; it < NITEMS; it += NGW) {
                int r = it;
                if (r < 2 * I_QKV) { const int l = r / I_QKV; r %= I_QKV; const int kb = r / 48, nb = r % 48; const float* wsrc = l == 0 ? A->in[I_NAQKV] : A->in[I_DQKV];
                    if ((DENSE_FP8 >> l) & 1) p0_item64_f8(wsrc, DM, 3 * DM, WQKV8 + (size_t)l * 6 * DM * DM, 64 * nb, 64 * kb, 64 * nb, scr, lane);
                    else { p0_transpose_item(wsrc, DM, 3 * DM, WQKV + (size_t)l * 3 * DM * DM, 64 * nb, 64 * kb, 64 * nb, scr, lane); p0_transpose_item(wsrc, DM, 3 * DM, WQKV + (size_t)l * 3 * DM * DM, 64 * nb + 32, 64 * kb, 64 * nb + 32, scr, lane); }
                    continue; }
                r -= 2 * I_QKV;
                if (r < 2 * I_WOI) { const int l = r / I_WOI; r %= I_WOI; const int kb = r / 16, nb = r % 16; const float* wsrc = l == 0 ? A->in[I_NAWO] : A->in[I_DWO];
                    if ((DENSE_FP8 >> (2 + l)) & 1) p0_item64_f8(wsrc, DM, DM, WO8 + (size_t)l * 2 * DM * DM, 64 * nb, 64 * kb, 64 * nb, scr, lane);
                    else { p0_transpose_item(wsrc, DM, DM, WO + (size_t)l * DM * DM, 64 * nb, 64 * kb, 64 * nb, scr, lane); p0_transpose_item(wsrc, DM, DM, WO + (size_t)l * DM * DM, 64 * nb + 32, 64 * kb, 64 * nb + 32, scr, lane); }
                    continue; }
            }
        }
    }
    END_PH();
    if (IN_PH()) { PH_BEGIN();
        for (int row = gw; row < NTOK; row += NGW) {
            const int mb = row < NLAT ? (row >> 14) : 2;
            f32x4 x[4], h[4]; ld_row_f32(x, src_row(A, row), lane);
            norm_mod(h, x, A->in[I_NMPRE], MOD + (size_t)mb * 6144 + DM, MOD + (size_t)mb * 6144, lane);
            if (DENSE_FP8 & 1) st_row_fp8(XNQ8 + (size_t)row * DM, h, lane); else st_row_bf16(XN + (size_t)row * DM, h, lane);
        }
    }
    END_PH();

#if MK_SPLIT
    run_layer<0>(F, lds, lo, hi, ph);
    run_layer<1>(F, lds, lo, hi, ph);
#else
    run_layer<0>(F, lds, lo, hi, ph, bar);
    run_layer<1>(F, lds, lo, hi, ph, bar);
#endif
}
constexpr int N_PHASES = 2 + 2 * 7 + 1;

extern "C" void kernel_launch(void* const* d_in, const int* in_sizes, int n_in, void* d_out, int out_size, void* d_ws, size_t ws_size, hipStream_t stream) {
    static int grid = 0;
    if (grid == 0) {
        if (n_in != 26 || in_sizes[0] != NLAT * DM || out_size != NLAT * DM || ws_size < WS_END) { fprintf(stderr, "kernel_launch: unexpected shapes: n_in %d in0 %d out %d ws %zu (need %zu)\n", n_in, n_in > 0 ? in_sizes[0] : -1, out_size, ws_size, (size_t)WS_END); grid = -1; return; }
        int dev = 0, cus = 0, per_cu = 0;
        if (hipGetDevice(&dev) != hipSuccess || hipDeviceGetAttribute(&cus, hipDeviceAttributeMultiprocessorCount, dev) != hipSuccess) { grid = -1; return; }
        if (hipFuncSetAttribute((const void*)mk_fwd, hipFuncAttributeMaxDynamicSharedMemorySize, LDS_BYTES) != hipSuccess) { fprintf(stderr, "kernel_launch: hipFuncSetAttribute failed\n"); grid = -1; return; }
        if (hipOccupancyMaxActiveBlocksPerMultiprocessor(&per_cu, (const void*)mk_fwd, NWAVES * 64, LDS_BYTES) != hipSuccess || per_cu < 1) fprintf(stderr, "kernel_launch: occupancy query reports %d\n", per_cu);
        (void)hipGetLastError();
        grid = cus;
    }
    if (grid < 0) return;
    if (hipMemsetAsync((char*)d_ws + WS_CTL, 0, CTL_ZERO_BYTES, stream) != hipSuccess) return;
    Args a{};
    for (int i = 0; i < 26; ++i) a.in[i] = (const float*)d_in[i];
    a.out = (float*)d_out; a.ws = (unsigned char*)d_ws;
#if MK_SPLIT
    for (int p = 0; p < N_PHASES; ++p) { a.ph_lo = p; a.ph_hi = p + 1; hipLaunchKernelGGL(mk_fwd, dim3(grid), dim3(NWAVES * 64), LDS_BYTES, stream, a); }
#else
    a.ph_lo = 0; a.ph_hi = N_PHASES;
    hipLaunchKernelGGL(mk_fwd, dim3(grid), dim3(NWAVES * 64), LDS_BYTES, stream, a);
#endif
    const hipError_t le = hipPeekAtLastError();
    if (le != hipSuccess) fprintf(stderr, "kernel_launch: launch failed: %s\n", hipGetErrorName(le));
}
```
